# Optimizing an MI355X kernel written in HIP

```python
import math
import jax, jax.numpy as jnp
from jax import lax
import numpy as np

D_MODEL = 2048
BATCH = 4
SEQ = 4096
DEPTH = 1

D_MIX = D_MODEL
D_SSM = D_MIX // 2
SSM_HEAD_DIM = 64
SSM_HEADS = D_SSM // SSM_HEAD_DIM
SSM_GROUPS = 2
D_STATE = 128
D_CONV = 5
CONV_PAD = D_CONV // 2
CONV_DIM = D_SSM + 2 * SSM_GROUPS * D_STATE
CHUNK = 128
MLA_HEADS = 8
QK_NOPE = 128
QK_ROPE = 64
V_DIM = 128
Q_LORA = 768
KV_LORA = 512
ROPE_THETA = 10000.0
Q_BLOCK = 128
IN_PROJ_DIM = D_SSM + CONV_DIM + 2 * SSM_HEADS + Q_LORA + KV_LORA + QK_ROPE
N_EXPERTS = 32
TOP_K = 4
D_EXPERT = D_MODEL
SWIGLU_ALPHA = 1.702
SWIGLU_LIMIT = 7.0
EXPERT_BLOCK = 128
RMS_EPS = 1e-6

kernel_name = "hymba_ssd_mla_moe_encoder"


def rms_norm(x, w, eps=RMS_EPS):
    xf = x.astype(jnp.float32)
    y = xf * lax.rsqrt(jnp.mean(xf * xf, axis=-1, keepdims=True) + eps)
    return (y * w.astype(jnp.float32)).astype(x.dtype)


def centred_depthwise_conv(u, w, b):
    out = lax.conv_general_dilated(
        u, w[:, None, :], window_strides=(1,), padding=[(CONV_PAD, CONV_PAD)],
        dimension_numbers=("NWC", "WIO", "NWC"), feature_group_count=u.shape[-1])
    return out + b


def segsum(a):
    cs = jnp.cumsum(a, axis=-1)
    diff = cs[..., :, None] - cs[..., None, :]
    L = a.shape[-1]
    mask = jnp.tril(jnp.ones((L, L), dtype=bool))
    return jnp.where(mask, diff, -jnp.inf)


def ssd_chunked(xdt, a, bm, cm):
    bsz, s, h, p = xdt.shape
    g, n = bm.shape[2], bm.shape[3]
    r = h // g
    nc = s // CHUNK
    x_c = xdt.reshape(bsz, nc, CHUNK, g, r, p)
    b_c = bm.reshape(bsz, nc, CHUNK, g, n)
    c_c = cm.reshape(bsz, nc, CHUNK, g, n)
    a_c = jnp.transpose(a.reshape(bsz, nc, CHUNK, g, r), (0, 3, 4, 1, 2))
    a_cs = jnp.cumsum(a_c, axis=-1)
    cb = jnp.einsum("bclgn,bcsgn->bgcls", c_c, b_c)
    scores = cb[:, :, None] * jnp.exp(segsum(a_c))
    y_diag = jnp.einsum("bgrcls,bcsgrp->bclgrp", scores, x_c)
    decay_in = jnp.exp(a_cs[..., -1:] - a_cs)
    states = jnp.einsum("bcsgn,bgrcs,bcsgrp->bcgrpn", b_c, decay_in, x_c)
    chunk_decay = jnp.exp(a_cs[..., -1])

    def step(carry, inp):
        st, dec = inp
        return carry * dec[..., None, None] + st, carry

    h0 = jnp.zeros(states.shape[:1] + states.shape[2:], states.dtype)
    _, prev = lax.scan(step, h0, (jnp.moveaxis(states, 1, 0), jnp.moveaxis(chunk_decay, -1, 0)))
    prev = jnp.moveaxis(prev, 0, 1)
    y_off = jnp.einsum("bclgn,bcgrpn,bgrcl->bclgrp", c_c, prev, jnp.exp(a_cs))
    return (y_diag + y_off).reshape(bsz, s, h, p)


def ssd_mixer(z, xbc, dt_raw_f, dt_raw_b, conv_w, conv_b, dt_bias_f, dt_bias_b,
              a_log_f, a_log_b, d_skip, gate_norm_w):
    bsz, s, _ = z.shape
    xbc = jax.nn.silu(centred_depthwise_conv(xbc, conv_w, conv_b))
    xs, bm, cm = jnp.split(xbc, [D_SSM, D_SSM + SSM_GROUPS * D_STATE], axis=-1)
    xs = xs.reshape(bsz, s, SSM_HEADS, SSM_HEAD_DIM)
    bm = bm.reshape(bsz, s, SSM_GROUPS, D_STATE)
    cm = cm.reshape(bsz, s, SSM_GROUPS, D_STATE)
    dt_f = jax.nn.softplus(dt_raw_f + dt_bias_f)
    dt_b = jax.nn.softplus(dt_raw_b + dt_bias_b)
    y_f = ssd_chunked(xs * dt_f[..., None], dt_f * -jnp.exp(a_log_f), bm, cm)
    rev = lambda t: jnp.flip(t, axis=1)
    y_b = rev(ssd_chunked(rev(xs * dt_b[..., None]), rev(dt_b * -jnp.exp(a_log_b)), rev(bm), rev(cm)))
    y = y_f + y_b + xs * d_skip[:, None]
    gs = D_SSM // SSM_GROUPS
    y = (y.reshape(bsz, s, D_SSM) * jax.nn.silu(z)).reshape(bsz, s, SSM_GROUPS, gs)
    y = rms_norm(y, gate_norm_w.reshape(SSM_GROUPS, gs))
    return y.reshape(bsz, s, D_SSM)


def rope_tables(positions, dtype):
    inv_freq = ROPE_THETA ** (-jnp.arange(0, QK_ROPE, 2, dtype=jnp.float32) / QK_ROPE)
    ang = positions.astype(jnp.float32)[..., None] * inv_freq
    ang = jnp.concatenate([ang, ang], axis=-1)
    return jnp.cos(ang).astype(dtype), jnp.sin(ang).astype(dtype)


def apply_rope(t, cos, sin):
    t1, t2 = jnp.split(t, 2, axis=-1)
    return t * cos + jnp.concatenate([-t2, t1], axis=-1) * sin


def mla_mixer(q_a, kv_a, k_pe, positions, q_a_norm_w, w_q_b, kv_a_norm_w, w_kv_b, o_norm_w):
    bsz, s, _ = q_a.shape
    q = (rms_norm(q_a, q_a_norm_w) @ w_q_b).reshape(bsz, s, MLA_HEADS, QK_NOPE + QK_ROPE)
    q_nope, q_pe = q[..., :QK_NOPE], q[..., QK_NOPE:]
    kv = (rms_norm(kv_a, kv_a_norm_w) @ w_kv_b).reshape(bsz, s, MLA_HEADS, QK_NOPE + V_DIM)
    k_nope, v = kv[..., :QK_NOPE], kv[..., QK_NOPE:]
    cos, sin = rope_tables(positions, q.dtype)
    q_pe = apply_rope(q_pe, cos[:, :, None], sin[:, :, None])
    k_pe = apply_rope(k_pe, cos, sin)
    scale = (QK_NOPE + QK_ROPE) ** -0.5
    nqb = s // Q_BLOCK
    to_blocks = lambda t: jnp.moveaxis(t.reshape(bsz, nqb, Q_BLOCK, *t.shape[2:]), 1, 0)

    def attend(blk):
        qn, qr = blk
        sc = (jnp.einsum("bqhd,bkhd->bhqk", qn, k_nope)
              + jnp.einsum("bqhr,bkr->bhqk", qr, k_pe))
        pr = jax.nn.softmax(sc.astype(jnp.float32), axis=-1).astype(v.dtype)
        return jnp.einsum("bhqk,bkhd->bqhd", pr, v)

    o = lax.map(attend, (to_blocks(q_nope * scale), to_blocks(q_pe * scale)))
    o = jnp.moveaxis(o, 0, 1).reshape(bsz, s, MLA_HEADS * V_DIM)
    return rms_norm(o, o_norm_w)


def moe_ffn(xn, w_router, b_router, w_gate_up, b_gate_up, w_down, b_down):
    bsz, s, d = xn.shape
    n_tok = bsz * s
    xt = xn.reshape(n_tok, d)
    logits = (xt @ w_router).astype(jnp.float32) + b_router.astype(jnp.float32)
    top_vals, top_idx = lax.top_k(logits, TOP_K)
    gates = jax.nn.softmax(top_vals, axis=-1)
    n_asg = n_tok * TOP_K
    flat_e = top_idx.reshape(n_asg)
    flat_tok = jnp.arange(n_asg, dtype=jnp.int32) // TOP_K
    order = jnp.argsort(flat_e)
    sorted_e = flat_e[order]
    counts = jnp.bincount(flat_e, length=N_EXPERTS)
    padded = (counts + EXPERT_BLOCK - 1) // EXPERT_BLOCK * EXPERT_BLOCK
    ends = jnp.cumsum(counts)
    pends = jnp.cumsum(padded)
    dest = (pends - padded)[sorted_e] + jnp.arange(n_asg, dtype=jnp.int32) - (ends - counts)[sorted_e]
    n_blocks = (n_asg + N_EXPERTS * (EXPERT_BLOCK - 1) + EXPERT_BLOCK - 1) // EXPERT_BLOCK
    n_rows = n_blocks * EXPERT_BLOCK
    row_tok = jnp.zeros((n_rows,), jnp.int32).at[dest].set(flat_tok[order])
    row_gate = jnp.zeros((n_rows,), jnp.float32).at[dest].set(gates.reshape(n_asg)[order])
    block_e = jnp.minimum(
        jnp.searchsorted(pends, jnp.arange(n_blocks, dtype=jnp.int32) * EXPERT_BLOCK, side="right"),
        N_EXPERTS - 1)

    def expert_block(args):
        tok, e, g = args
        hdn = xt[tok] @ w_gate_up[e] + b_gate_up[e]
        glu = jnp.minimum(hdn[:, ::2], SWIGLU_LIMIT)
        lin = jnp.clip(hdn[:, 1::2], -SWIGLU_LIMIT, SWIGLU_LIMIT)
        act = glu * jax.nn.sigmoid(SWIGLU_ALPHA * glu) * (lin + 1.0)
        y = act @ w_down[e] + b_down[e]
        return y * g[:, None].astype(y.dtype)

    y = lax.map(expert_block, (row_tok.reshape(n_blocks, EXPERT_BLOCK), block_e,
                               row_gate.reshape(n_blocks, EXPERT_BLOCK)))
    out = jnp.zeros_like(xt).at[row_tok].add(y.reshape(n_rows, d))
    return out.reshape(bsz, s, d)


def setup_inputs(seed: int = 0) -> dict:
    key = jax.random.key(seed)
    ks = jax.random.split(key, 32)
    nrm = lambda k, shape, sc: jax.random.normal(k, shape, jnp.float32) * sc
    gain = lambda k, shape: 1.0 + 0.02 * jax.random.normal(k, shape, jnp.float32)

    def dt_bias(k):
        u = jax.random.uniform(k, (DEPTH, SSM_HEADS), jnp.float32)
        dt = jnp.exp(u * (math.log(0.1) - math.log(0.001)) + math.log(0.001))
        dt = jnp.maximum(dt, 1e-4)
        return dt + jnp.log(-jnp.expm1(-dt))

    a_log = lambda k: jnp.log(jax.random.uniform(k, (DEPTH, SSM_HEADS), jnp.float32, 1.0, 16.0))
    positions = (jnp.arange(SEQ, dtype=jnp.int32)[None, :]
                 + jax.random.randint(ks[1], (BATCH, 1), 0, SEQ, dtype=jnp.int32))
    return {
        "x": jax.random.normal(ks[0], (BATCH, SEQ, D_MODEL), jnp.float32),
        "positions": positions,
        "norm1_w": gain(ks[2], (DEPTH, D_MODEL)),
        "w_in": nrm(ks[3], (DEPTH, D_MODEL, IN_PROJ_DIM), D_MODEL ** -0.5),
        "conv_w": nrm(ks[4], (DEPTH, D_CONV, CONV_DIM), D_CONV ** -0.5),
        "conv_b": nrm(ks[5], (DEPTH, CONV_DIM), 0.01),
        "dt_bias_f": dt_bias(ks[6]),
        "dt_bias_b": dt_bias(ks[7]),
        "a_log_f": a_log(ks[8]),
        "a_log_b": a_log(ks[9]),
        "d_skip": 1.0 + 0.1 * jax.random.normal(ks[10], (DEPTH, SSM_HEADS), jnp.float32),
        "ssm_norm_w": gain(ks[11], (DEPTH, D_SSM)),
        "q_a_norm_w": gain(ks[12], (DEPTH, Q_LORA)),
        "w_q_b": nrm(ks[13], (DEPTH, Q_LORA, MLA_HEADS * (QK_NOPE + QK_ROPE)), Q_LORA ** -0.5),
        "kv_a_norm_w": gain(ks[14], (DEPTH, KV_LORA)),
        "w_kv_b": nrm(ks[15], (DEPTH, KV_LORA, MLA_HEADS * (QK_NOPE + V_DIM)), KV_LORA ** -0.5),
        "attn_norm_w": gain(ks[16], (DEPTH, MLA_HEADS * V_DIM)),
        "w_out": nrm(ks[17], (DEPTH, D_MIX, D_MODEL), D_MIX ** -0.5),
        "norm2_w": gain(ks[18], (DEPTH, D_MODEL)),
        "w_router": nrm(ks[19], (DEPTH, D_MODEL, N_EXPERTS), D_MODEL ** -0.5),
        "b_router": nrm(ks[20], (DEPTH, N_EXPERTS), 0.01),
        "w_gate_up": nrm(ks[21], (DEPTH, N_EXPERTS, D_MODEL, 2 * D_EXPERT), D_MODEL ** -0.5),
        "b_gate_up": nrm(ks[22], (DEPTH, N_EXPERTS, 2 * D_EXPERT), 0.01),
        "w_down": nrm(ks[23], (DEPTH, N_EXPERTS, D_EXPERT, D_MODEL), D_EXPERT ** -0.5),
        "b_down": nrm(ks[24], (DEPTH, N_EXPERTS, D_MODEL), 0.01),
        "final_norm_w": gain(ks[25], (D_MODEL,)),
    }


def reference(x, positions, norm1_w, w_in, conv_w, conv_b, dt_bias_f, dt_bias_b, a_log_f, a_log_b,
              d_skip, ssm_norm_w, q_a_norm_w, w_q_b, kv_a_norm_w, w_kv_b, attn_norm_w, w_out,
              norm2_w, w_router, b_router, w_gate_up, b_gate_up, w_down, b_down, final_norm_w):
    split_at = np.cumsum([D_SSM, CONV_DIM, SSM_HEADS, SSM_HEADS, Q_LORA, KV_LORA]).tolist()
    h = x
    for l in range(DEPTH):
        xn = rms_norm(h, norm1_w[l])
        proj = xn @ w_in[l]
        z, xbc, dt_f, dt_b, q_a, kv_a, k_pe = jnp.split(proj, split_at, axis=-1)
        y_ssm = ssd_mixer(z, xbc, dt_f, dt_b, conv_w[l], conv_b[l], dt_bias_f[l], dt_bias_b[l],
                          a_log_f[l], a_log_b[l], d_skip[l], ssm_norm_w[l])
        y_att = mla_mixer(q_a, kv_a, k_pe, positions, q_a_norm_w[l], w_q_b[l],
                          kv_a_norm_w[l], w_kv_b[l], attn_norm_w[l])
        h = h + jnp.concatenate([y_ssm, y_att], axis=-1) @ w_out[l]
        h = h + moe_ffn(rms_norm(h, norm2_w[l]), w_router[l], b_router[l], w_gate_up[l],
                        b_gate_up[l], w_down[l], b_down[l])
    return rms_norm(h, final_norm_w)
```

```cpp
#include <hip/hip_runtime.h>
#include <cstdio>
#include <cstdint>

#ifndef MK_N_LAUNCHES
#define MK_N_LAUNCHES 1
#endif
#ifndef DBG_PROBE
#define DBG_PROBE 0
#define DBG_PROBE_F32 0
#define DBG_PROBE_OFF WS_YCAT
#define DBG_PROBE_LD 2048
#endif
#ifndef DBG_REP
#define DBG_REP 0
#endif
#ifndef DBG_REP0
#define DBG_REP0 0
#endif
#ifndef DBG_REP8
#define DBG_REP8 0
#endif
#ifndef DBG_NO_SSM
#define DBG_NO_SSM 0
#endif
#ifndef DBG_NO_ATT
#define DBG_NO_ATT 0
#endif
#ifndef DBG_NO_MOE
#define DBG_NO_MOE 0
#endif

constexpr int BATCH = 4, SEQ = 4096, NT = BATCH * SEQ, DM = 2048;
constexpr int D_SSM = 1024, SSM_HEADS = 16, HDIM = 64, NGRP = 2, DSTATE = 128, CHUNK = 128, NCHUNK = SEQ / CHUNK;
constexpr int CONV_DIM = 1536;
constexpr int MLA_H = 8, QK_NOPE = 128, QK_ROPE = 64, QKD = 192, VD = 128, Q_LORA = 768, KV_LORA = 512;
constexpr int IN_PROJ = 3936, NPROJ = 3840  , NIN_PAD = 4096;
constexpr int NEXP = 32, TOPK = 4, DEXP = 2048;
constexpr float RMS_EPS = 1e-6f;
constexpr int MAX_TILES = 288, MAX_ROWS = MAX_TILES * 256;
constexpr int NPHASE = 11;

constexpr int PC_Z = 0, PC_XS = 1024, PC_B = 2048, PC_C = 2304, PC_QA = 2560, PC_KVA = 3328;

constexpr size_t MiB = 1u << 20;
constexpr size_t WS_CTL = 0, CTL_ZERO_BYTES = 1 * MiB;
constexpr size_t WS_WIN = 1 * MiB;
constexpr size_t WS_WQB = 17 * MiB;
constexpr size_t WS_WKVB = 20 * MiB;
constexpr size_t WS_WOUT = 22 * MiB;
constexpr size_t WS_ROPE = 30 * MiB;
constexpr size_t WS_DT = 34 * MiB;
constexpr size_t WS_DTA = 36 * MiB;
constexpr size_t WS_CD = 40 * MiB;
constexpr size_t WS_KPE = 41 * MiB;
constexpr size_t WS_TOKE = 43 * MiB;
constexpr size_t WS_TOKP = WS_TOKE + 256 * 1024;
constexpr size_t WS_TOKG = WS_TOKE + 512 * 1024;
constexpr size_t WS_TOKR = WS_TOKE + 768 * 1024;
constexpr size_t WS_RTS = 44 * MiB;
constexpr size_t WS_WRT = 46 * MiB;
constexpr size_t WS_SSP = 47 * MiB;
constexpr size_t WS_SS2P = 49 * MiB;
constexpr size_t WS_XN = 64 * MiB;
constexpr size_t WS_PROJ = 128 * MiB;
constexpr size_t WS_Q = 256 * MiB;
constexpr size_t WS_KN = 304 * MiB;
constexpr size_t WS_V = 336 * MiB;
constexpr size_t WS_O = 368 * MiB;
constexpr size_t WS_XT = 432 * MiB;
constexpr size_t WS_BC = 464 * MiB;
constexpr size_t WS_ST = 480 * MiB;
constexpr size_t WS_YCAT = 608 * MiB;
constexpr size_t WS_H = 672 * MiB;
constexpr size_t WS_XG = 800 * MiB;
constexpr size_t WS_ACT = 1088 * MiB;
constexpr size_t WS_Y = 1376 * MiB;
constexpr size_t WS_WGU = 1664 * MiB;
constexpr size_t WS_WDN = 2176 * MiB;
constexpr size_t WS_END = 2432 * MiB;
constexpr int CW_BAR = 4096;
constexpr int CW_CNT = 8192;

constexpr int RING_BYTES = 131072;
constexpr int MISC_OFF = RING_BYTES;
constexpr int LDS_BYTES = 147456;
constexpr int NWAVES = 8;

#define GAS __attribute__((address_space(1)))
#define LAS __attribute__((address_space(3)))
typedef unsigned short bf16;
typedef unsigned v4u __attribute__((ext_vector_type(4)));
typedef unsigned v2u __attribute__((ext_vector_type(2)));
typedef float f32x4 __attribute__((ext_vector_type(4)));
typedef float f32x2 __attribute__((ext_vector_type(2)));
typedef float f32x16 __attribute__((ext_vector_type(16)));
typedef short bf16x8 __attribute__((ext_vector_type(8)));
typedef short s16x4 __attribute__((ext_vector_type(4)));
typedef GAS unsigned gu32;
#define RLX_AGENT __ATOMIC_RELAXED, __HIP_MEMORY_SCOPE_AGENT
#define LDS_WAIT() asm volatile("s_waitcnt lgkmcnt(0)" ::: "memory")
#define VM_WAIT() asm volatile("s_waitcnt vmcnt(0)" ::: "memory")

typedef __bf16 bfx2_t __attribute__((ext_vector_type(2)));
__device__ __forceinline__ unsigned cvt_pk_bf16(float lo, float hi) { const f32x2 v = {lo, hi}; const bfx2_t r = __builtin_convertvector(v, bfx2_t); return __builtin_bit_cast(unsigned, r); }
__device__ __forceinline__ float bf_lo(unsigned u) { return __uint_as_float(u << 16); }
__device__ __forceinline__ float bf_hi(unsigned u) { return __uint_as_float(u & 0xffff0000u); }
__device__ __forceinline__ float wave_sum(float v) {
#pragma unroll
    for (int o = 1; o < 64; o <<= 1) v += __shfl_xor(v, o);
    return v;
}
__device__ __forceinline__ float silu_f(float v) { return v * __builtin_amdgcn_rcpf(1.f + __expf(-v)); }

#define XB_TMO      128
#define XB_XCNT(j)  (256  + 64 * (j))
#define XB_XSUB(j)  (1280 + 64 * (j))
#define XB_XGEN(j)  (2304 + 64 * (j))
#define XB_TOP      3328
#define XB_TOPGEN   3392
#define XCD_BAR_WORDS 3456
#define XB_SPIN_CAP (1u << 18)

__device__ __forceinline__ unsigned xb_ld(unsigned* p)              { return __hip_atomic_load(p, __ATOMIC_RELAXED, __HIP_MEMORY_SCOPE_AGENT); }
__device__ __forceinline__ unsigned xb_add(unsigned* p, unsigned v) { return __hip_atomic_fetch_add(p, v, __ATOMIC_RELAXED, __HIP_MEMORY_SCOPE_AGENT); }
__device__ __forceinline__ unsigned xb_xcc_id() { return (unsigned)__builtin_amdgcn_s_getreg((3 << 11) | 20) & 0xFu; }
#define XB_SPIN(cond, bar) do { unsigned _sp = 0; while (cond) { __builtin_amdgcn_s_sleep(1); \
    if ((++_sp & 255u) == 0u) { if (xb_ld(&(bar)[XB_TMO])) break; if (_sp > XB_SPIN_CAP) { atomicAdd(&(bar)[XB_TMO], 1u); break; } } } } while (0)

struct XcdBarrier { unsigned* bar; unsigned x; volatile LAS unsigned* st; };

__device__ __forceinline__ XcdBarrier xcd_barrier_post(unsigned* bar, volatile LAS unsigned* st) {
    XcdBarrier b; b.bar = bar; b.x = xb_xcc_id(); b.st = st;
    if (threadIdx.x == 0) (void)xb_add(&bar[XB_XCNT(b.x)], 1u);
    return b;
}
__device__ __forceinline__ void xcd_barrier_complete(unsigned* bar, unsigned x, unsigned& nloc, unsigned& nx) {
    const unsigned G = gridDim.x * gridDim.y * gridDim.z;
    unsigned sum, cnt, mine, sp = 0u;
    for (;;) {
        sum = 0u; cnt = 0u; mine = 0u;
#pragma unroll
        for (unsigned j = 0; j < 16; ++j) { const unsigned c = xb_ld(&bar[XB_XCNT(j)]); sum += c; cnt += (c > 0u) ? 1u : 0u; mine = (j == x) ? c : mine; }
        if (sum == G) break;
        __builtin_amdgcn_s_sleep(1);
        if ((++sp & 255u) == 0u) { if (xb_ld(&bar[XB_TMO])) break; if (sp > XB_SPIN_CAP) { atomicAdd(&bar[XB_TMO], 1u); break; } }
    }
    nloc = mine > 0u ? mine : 1u; nx = cnt > 0u ? cnt : 1u;
}
__device__ __forceinline__ void xcd_barrier(const XcdBarrier& b) {
    asm volatile("s_waitcnt vmcnt(0)" ::: "memory");
    __syncthreads();
    if (threadIdx.x == 0) {
        unsigned* bar = b.bar;
        __builtin_amdgcn_s_waitcnt(0);
        unsigned nloc = b.st[0], nx = b.st[1];
        if (nloc == 0u) { xcd_barrier_complete(bar, b.x, nloc, nx); b.st[0] = nloc; b.st[1] = nx; }
        const unsigned old = xb_add(&bar[XB_XSUB(b.x)], 1u);
        const unsigned gen = old / nloc;
        if (old + 1u == (gen + 1u) * nloc) {
            __builtin_amdgcn_fence(__ATOMIC_RELEASE, "agent");
            asm volatile("s_waitcnt vmcnt(0)" ::: "memory");
            const unsigned og = xb_add(&bar[XB_TOP], 1u);
            const unsigned tg = og / nx;
            if (og + 1u == (tg + 1u) * nx) xb_add(&bar[XB_TOPGEN], 1u);
            else XB_SPIN(xb_ld(&bar[XB_TOPGEN]) == tg, bar);
            __builtin_amdgcn_fence(__ATOMIC_ACQUIRE, "agent");
            xb_add(&bar[XB_XGEN(b.x)], 1u);
            asm volatile("s_waitcnt vmcnt(0)" ::: "memory");
        } else {
            XB_SPIN(xb_ld(&bar[XB_XGEN(b.x)]) == gen, bar);
            __builtin_amdgcn_fence(__ATOMIC_ACQUIRE, "agent");
            asm volatile("s_waitcnt vmcnt(0)" ::: "memory");
        }
    }
    __syncthreads();
}

namespace pg8 {
constexpr int BM = 256, BK = 64, HALF = 128, HTB = HALF * BK * 2, STAGE_BYTES = 8 * HTB;
__device__ __forceinline__ int lds_byte(int r, int c) { const int st = (r >> 4) * 2 + (c >> 5), rr = r & 15, cc = c & 31, ob = rr * 64 + cc * 2; return st * 1024 + (ob ^ (((ob >> 9) & 1) << 5)); }
__device__ __forceinline__ void stage_rc(int b, int& R, int& C) { const int st = b / 1024, sb = b % 1024, swz = sb ^ (((sb >> 9) & 1) << 5); R = (st >> 1) * 16 + swz / 64; C = (st & 1) * 32 + (swz % 64) / 2; }
__device__ __forceinline__ int perm32(int rho) { const int n = rho >> 4, i = rho & 15; return 8 * (i >> 2) + 4 * n + (i & 3); }

typedef int v8i_t __attribute__((ext_vector_type(8)));
__device__ __forceinline__ v8i_t cat8(bf16x8 lo, bf16x8 hi) { const v4u a = __builtin_bit_cast(v4u, lo), b = __builtin_bit_cast(v4u, hi); return (v8i_t){(int)a.x, (int)a.y, (int)a.z, (int)a.w, (int)b.x, (int)b.y, (int)b.z, (int)b.w}; }
struct Unit { const char* A0; const char* B0; int pm, pn, e; };
struct Geo { int lda, ldb, K; };

template <bool FP8, class Epi, class Sched, bool BNT = false, bool GATHER = false>
__device__ __forceinline__ void gemm_phase(LAS unsigned char* lds, const Geo g, const Sched& S, const Epi& E) {
    const int tid = threadIdx.x, wid = __builtin_amdgcn_readfirstlane(tid >> 6), lane = tid & 63, wr = wid >> 2, wc = wid & 3, fr = lane & 15, fq = lane >> 4;
    const int K = g.K, nt = K / BK;
    unsigned voffA[2], voffB[2];
    unsigned voffC[2][2], voffN[2][2], cofs[2]; int rsel[2];
    constexpr bool PERM16 = FP8;
#pragma unroll
    for (int i = 0; i < 2; ++i) { int R, C; stage_rc(tid * 16 + i * 8192, R, C); const int p = perm32(R & 31);
        const int Rb = PERM16 ? (64 * (R >> 5) + p + (p & 24)) : ((R & ~31) + p);
        voffA[i] = (unsigned)(R * g.lda + C) * 2u; voffB[i] = (unsigned)(Rb * g.ldb + C) * 2u; cofs[i] = (unsigned)C * 2u; rsel[i] = R; }
    const size_t kstep = (size_t)(BK * 2);
    const size_t hstepA = (size_t)HALF * g.lda * 2, hstepB = (size_t)(PERM16 ? 8 : HALF) * g.ldb * 2;
    const unsigned ldsw = (unsigned)wid * 1024u;
    const int aoff = lds_byte(wr * 64 + fr, fq * 8), boff = lds_byte(wc * 32 + fr, fq * 8);
#define PG8_SA(b, h) (((b) * 2 + (h)) * HTB)
#define PG8_SB(b, h) ((4 + (b) * 2 + (h)) * HTB)
#define PG8_STAGE(bufoff, gbase, voff) do { _Pragma("unroll") for (int _i = 0; _i < 2; ++_i) \
        __builtin_amdgcn_global_load_lds((const unsigned*)((const char*)(gbase) + (voff)[_i]), (LAS unsigned*)(lds + (bufoff) + ldsw + _i * 8192), 16, 0, 0); } while (0)
#define PG8_STAGE_NT(bufoff, gbase, voff) do { _Pragma("unroll") for (int _i = 0; _i < 2; ++_i) \
        __builtin_amdgcn_global_load_lds((const unsigned*)((const char*)(gbase) + (voff)[_i]), (LAS unsigned*)(lds + (bufoff) + ldsw + _i * 8192), 16, 0, BNT ? 2 : 0); } while (0)
#define PG8_LD8(p) ({ const v4u lo_ = *(const LAS v4u*)(p), hi_ = *(const LAS v4u*)((p) + 1024); (v8i_t){(int)lo_.x, (int)lo_.y, (int)lo_.z, (int)lo_.w, (int)hi_.x, (int)hi_.y, (int)hi_.z, (int)hi_.w}; })
#define PG8_LDA(dst, b, h) do { if constexpr (FP8) { _Pragma("unroll") for (int m = 0; m < 4; ++m) dst##8[m] = PG8_LD8(lds + PG8_SA(b, h) + aoff + m * 2048); } \
        else { _Pragma("unroll") for (int m = 0; m < 4; ++m) _Pragma("unroll") for (int k = 0; k < 2; ++k) dst[m][k] = *(const LAS bf16x8*)(lds + PG8_SA(b, h) + aoff + m * 2048 + k * 1024); } } while (0)
#define PG8_LDB(dst, b, h) do { if constexpr (FP8) { _Pragma("unroll") for (int n = 0; n < 2; ++n) dst##8[n] = PG8_LD8(lds + PG8_SB(b, h) + boff + n * 2048); } \
        else { _Pragma("unroll") for (int n = 0; n < 2; ++n) _Pragma("unroll") for (int k = 0; k < 2; ++k) dst[n][k] = *(const LAS bf16x8*)(lds + PG8_SB(b, h) + boff + n * 2048 + k * 1024); } } while (0)
#define PG8_MMA(ai, bj, At, Bt) do { if constexpr (!FP8) __builtin_amdgcn_s_setprio(1); \
        if constexpr (FP8) { _Pragma("unroll") for (int m = 0; m < 4; ++m) _Pragma("unroll") for (int n = 0; n < 2; ++n) \
            asm volatile("v_mfma_f32_16x16x128_f8f6f4 %0, %1, %2, %0" : "+v"(acc[ai][bj][m][n]) : "v"(Bt##8[n]), "v"(At##8[m])); } \
        else { _Pragma("unroll") for (int m = 0; m < 4; ++m) _Pragma("unroll") for (int n = 0; n < 2; ++n) _Pragma("unroll") for (int k = 0; k < 2; ++k) \
            acc[ai][bj][m][n] = __builtin_amdgcn_mfma_f32_16x16x32_bf16(Bt[n][k], At[m][k], acc[ai][bj][m][n], 0, 0, 0); } \
        if constexpr (!FP8) __builtin_amdgcn_s_setprio(0); } while (0)
#define PG8_AOFF(h, nx) (GATHER ? ((nx) ? voffN[h] : voffC[h]) : voffA)
#define PG8_AH(h) (GATHER ? (size_t)0 : (size_t)(h) * hstepA)
#define PG8_WAIT_V(n) asm volatile("s_waitcnt vmcnt(" #n ")" ::: "memory")
#define PG8_WAIT_L(n) asm volatile("s_waitcnt lgkmcnt(" #n ")" ::: "memory")
#define PG8_BAR __builtin_amdgcn_s_barrier()
#define PG8_SCHED __builtin_amdgcn_sched_barrier(0)
    Unit cur, nxt; int ui = 0;
    if (!S.next(0, cur)) return;
    f32x4 acc[2][2][4][2];
#pragma unroll
    for (int a = 0; a < 2; ++a)
#pragma unroll
        for (int b = 0; b < 2; ++b)
#pragma unroll
            for (int m = 0; m < 4; ++m)
#pragma unroll
                for (int n = 0; n < 2; ++n) acc[a][b][m][n] = (f32x4){0.f, 0.f, 0.f, 0.f};
    bf16x8 At[4][2], B0[2][2], B1[2][2]; v8i_t At8[4], B08[2], B18[2];
    const char* cA = cur.A0; const char* cB = cur.B0;
    if constexpr (GATHER) { const int* rt = S.rowtab(cur);
#pragma unroll
        for (int h = 0; h < 2; ++h)
#pragma unroll
            for (int i = 0; i < 2; ++i) voffC[h][i] = (unsigned)rt[h * HALF + rsel[i]] * (unsigned)(g.lda * 2) + cofs[i]; }
    PG8_STAGE_NT(PG8_SB(0, 0), cB, voffB); PG8_STAGE(PG8_SA(0, 0), cA + PG8_AH(0), PG8_AOFF(0, false)); PG8_STAGE_NT(PG8_SB(0, 1), cB + hstepB, voffB); PG8_STAGE(PG8_SA(0, 1), cA + PG8_AH(1), PG8_AOFF(1, false));
    if (wr == 1) PG8_BAR;
    PG8_WAIT_V(4); PG8_BAR;
    PG8_STAGE_NT(PG8_SB(1, 0), cB + kstep, voffB); PG8_STAGE(PG8_SA(1, 0), cA + kstep + PG8_AH(0), PG8_AOFF(0, false)); PG8_STAGE_NT(PG8_SB(1, 1), cB + hstepB + kstep, voffB);
    PG8_WAIT_V(6); PG8_BAR;
    for (;;) {
        const bool has_next = S.next(ui + 1, nxt);
        if constexpr (GATHER) { if (has_next) { const int* rt = S.rowtab(nxt);
#pragma unroll
            for (int h = 0; h < 2; ++h)
#pragma unroll
                for (int i = 0; i < 2; ++i) asm volatile("global_load_dword %0, %1, off" : "=v"(voffN[h][i]) : "v"(rt + h * HALF + rsel[i]) : "memory"); } }
        const auto pf = E.prefetch(cur, wr, wc, fr, fq);
        const char* nA = has_next ? nxt.A0 : cA; const char* nB = has_next ? nxt.B0 : cB;
        for (int t = 0; t < nt; t += 2) {
            const bool last = (t == nt - 2);
            const char* a1 = cA + (size_t)(t + 1) * kstep;
            const char* a2 = last ? nA : cA + (size_t)(t + 2) * kstep; const char* b2 = last ? nB : cB + (size_t)(t + 2) * kstep;
            const char* a3 = a2 + kstep; const char* b3 = b2 + kstep;
            const bool nxf = last && has_next;
            if constexpr (GATHER) { if (nxf) {
#pragma unroll
                for (int h = 0; h < 2; ++h)
#pragma unroll
                    for (int i = 0; i < 2; ++i) voffN[h][i] = voffN[h][i] * (unsigned)(g.lda * 2) + cofs[i]; } }
            PG8_LDB(B0, 0, 0); PG8_SCHED; PG8_LDA(At, 0, 0); PG8_STAGE(PG8_SA(1, 1), a1 + PG8_AH(1), PG8_AOFF(1, false));
            PG8_WAIT_L(8); PG8_BAR; PG8_WAIT_L(0); PG8_MMA(0, 0, At, B0); PG8_BAR; PG8_SCHED;
            PG8_LDB(B1, 0, 1); PG8_STAGE_NT(PG8_SB(0, 0), b2, voffB);
            PG8_BAR; PG8_WAIT_L(0); PG8_MMA(0, 1, At, B1); PG8_BAR;
            PG8_LDA(At, 0, 1); PG8_STAGE(PG8_SA(0, 0), a2 + PG8_AH(0), PG8_AOFF(0, nxf));
            PG8_BAR; PG8_WAIT_L(0); PG8_MMA(1, 0, At, B0); PG8_BAR; PG8_SCHED;
            PG8_STAGE_NT(PG8_SB(0, 1), b2 + hstepB, voffB);
            PG8_WAIT_V(6); PG8_BAR; PG8_MMA(1, 1, At, B1); PG8_BAR;
            PG8_LDB(B0, 1, 0); PG8_SCHED; PG8_LDA(At, 1, 0); PG8_STAGE(PG8_SA(0, 1), a2 + PG8_AH(1), PG8_AOFF(1, nxf));
            PG8_WAIT_L(8); PG8_BAR; PG8_WAIT_L(0); PG8_MMA(0, 0, At, B0); PG8_BAR; PG8_SCHED;
            PG8_LDB(B1, 1, 1); PG8_STAGE_NT(PG8_SB(1, 0), b3, voffB);
            PG8_BAR; PG8_WAIT_L(0); PG8_MMA(0, 1, At, B1); PG8_BAR;
            PG8_LDA(At, 1, 1); PG8_STAGE(PG8_SA(1, 0), a3 + PG8_AH(0), PG8_AOFF(0, nxf));
            PG8_BAR; PG8_WAIT_L(0); PG8_MMA(1, 0, At, B0); PG8_BAR; PG8_SCHED;
            PG8_STAGE_NT(PG8_SB(1, 1), b3 + hstepB, voffB);
            PG8_WAIT_V(6); PG8_BAR; PG8_MMA(1, 1, At, B1); PG8_BAR;
        }
        if constexpr (FP8) asm volatile("s_nop 15\n\ts_nop 15" ::: "memory");
        E(acc, cur, wr, wc, fr, fq, pf);
        if (!has_next) break;
#pragma unroll
        for (int a = 0; a < 2; ++a)
#pragma unroll
            for (int b = 0; b < 2; ++b)
#pragma unroll
                for (int m = 0; m < 4; ++m)
#pragma unroll
                    for (int n = 0; n < 2; ++n) acc[a][b][m][n] = (f32x4){0.f, 0.f, 0.f, 0.f};
        cur = nxt; cA = nA; cB = nB; ++ui;
        if constexpr (GATHER) {
#pragma unroll
            for (int h = 0; h < 2; ++h)
#pragma unroll
                for (int i = 0; i < 2; ++i) voffC[h][i] = voffN[h][i]; }
    }
    PG8_WAIT_V(0);
    if (wr == 0) PG8_BAR;
    PG8_BAR;
#undef PG8_SA
#undef PG8_SB
#undef PG8_STAGE
#undef PG8_STAGE_NT
#undef PG8_LDA
#undef PG8_LDB
#undef PG8_MMA
#undef PG8_WAIT_V
#undef PG8_AOFF
#undef PG8_AH
#undef PG8_WAIT_L
#undef PG8_BAR
#undef PG8_SCHED
}

struct DenseOrder {
    const char* A; const char* Bt; size_t tstepA, tstepB; int nM, nN, nwg, G, c;
    __device__ void init(const void* A_, int lda, const void* Bt_, int ldb, int M, int N, int G_, int c_) {
        A = (const char*)A_; Bt = (const char*)Bt_; tstepA = (size_t)BM * lda * 2; tstepB = (size_t)BM * ldb * 2; nM = M / BM; nN = N / BM; nwg = nM * nN; G = G_; c = c_; }
    int skew = 0;
    __device__ bool next(int i, Unit& u) const {
        long L = (long)i * G + c;
        if (skew) { const int hG = G >> 1; if (c < hG) { if (i > 0) return false; L = c; } else { if (i > 2) return false; L = (i == 0) ? c : (c + hG * i); } }
        if (L >= nwg) return false;
        int wgid = (int)L; { const int q = nwg / 8, r = nwg % 8, xcd = wgid % 8, off = wgid / 8; wgid = (xcd < r ? xcd * (q + 1) : r * (q + 1) + (xcd - r) * q) + off; }
        const int nig = 8 * nN, gid = wgid / nig, fm = gid * 8, gsz = (nM - fm) < 8 ? (nM - fm) : 8;
        u.pm = fm + ((wgid % nig) % gsz); u.pn = (wgid % nig) / gsz; u.e = 0;
        u.A0 = A + (size_t)u.pm * tstepA; u.B0 = Bt + (size_t)u.pn * tstepB; return true;
    }
};
}

typedef const f32x4 (&AccRef)[2][2][4][2];
struct NoPf {};
struct BiasPf { f32x4 bv[2][2]; };
struct RsPf { float rs[2][4]; };
__device__ __forceinline__ v4u pack8(f32x4 v0, f32x4 v1) { v4u w; w.x = cvt_pk_bf16(v0[0], v0[1]); w.y = cvt_pk_bf16(v0[2], v0[3]); w.z = cvt_pk_bf16(v1[0], v1[1]); w.w = cvt_pk_bf16(v1[2], v1[3]); return w; }
__device__ __forceinline__ void rope4(f32x4& v0, f32x4& v1, const float* cs  ) {
    const f32x4 a = *(const f32x4*)cs, b = *(const f32x4*)(cs + 4);
    float t1, t2;
    t1 = v0[0]; t2 = v0[1]; v0[0] = t1 * a[0] - t2 * a[1]; v0[1] = t2 * a[0] + t1 * a[1];
    t1 = v0[2]; t2 = v0[3]; v0[2] = t1 * a[2] - t2 * a[3]; v0[3] = t2 * a[2] + t1 * a[3];
    t1 = v1[0]; t2 = v1[1]; v1[0] = t1 * b[0] - t2 * b[1]; v1[1] = t2 * b[0] + t1 * b[1];
    t1 = v1[2]; t2 = v1[3]; v1[2] = t1 * b[2] - t2 * b[3]; v1[3] = t2 * b[2] + t1 * b[3];
}

struct EpiInProj {
    bf16* PROJ; bf16* KPE; float* DT; float* ssp; const float* rope;
    __device__ __forceinline__ NoPf prefetch(const pg8::Unit&, int, int, int, int) const { return NoPf{}; }
    __device__ __forceinline__ void operator()(AccRef acc, const pg8::Unit& u, int wr, int wc, int fr, int fq, const NoPf&) const {
        const int row0 = u.pm * 256 + wr * 64 + fr;
        if (u.pn < 15) {
            const int col0 = u.pn * 256 + wc * 32 + 8 * fq;
            const bool wss = u.pn >= 10;
#pragma unroll
            for (int ai = 0; ai < 2; ++ai)
#pragma unroll
                for (int m = 0; m < 4; ++m) {
                    const int row = row0 + ai * 128 + m * 16; float s = 0.f;
#pragma unroll
                    for (int bj = 0; bj < 2; ++bj) {
                        const f32x4 v0 = acc[ai][bj][m][0], v1 = acc[ai][bj][m][1];
                        *(v4u*)(PROJ + (size_t)row * NPROJ + col0 + bj * 128) = pack8(v0, v1);
                        s += v0[0] * v0[0] + v0[1] * v0[1] + v0[2] * v0[2] + v0[3] * v0[3] + v1[0] * v1[0] + v1[1] * v1[1] + v1[2] * v1[2] + v1[3] * v1[3];
                    }
                    if (wss) { s += __shfl_xor(s, 16); s += __shfl_xor(s, 32); if (fq == 0) ssp[(size_t)row * 20 + (u.pn - 10) * 4 + wc] = s; }
                }
        } else {
            if (wc < 2) {
#pragma unroll
                for (int ai = 0; ai < 2; ++ai)
#pragma unroll
                    for (int m = 0; m < 4; ++m) {
                        const int row = row0 + ai * 128 + m * 16;
                        f32x4 v0 = acc[ai][0][m][0], v1 = acc[ai][0][m][1];
                        rope4(v0, v1, rope + (size_t)row * 64 + 2 * (16 * wc + 4 * fq));
                        *(v4u*)(KPE + (size_t)row * 64 + 32 * wc + 8 * fq) = pack8(v0, v1);
                    }
            } else if (wc == 2) {
#pragma unroll
                for (int ai = 0; ai < 2; ++ai)
#pragma unroll
                    for (int m = 0; m < 4; ++m) {
                        const int row = row0 + ai * 128 + m * 16;
                        *(f32x4*)(DT + (size_t)row * 32 + 8 * fq) = acc[ai][0][m][0];
                        *(f32x4*)(DT + (size_t)row * 32 + 8 * fq + 4) = acc[ai][0][m][1];
                    }
            }
        }
    }
};

struct EpiQB {
    bf16* Q; const float* ssp; const float* rope;
    __device__ __forceinline__ NoPf prefetch(const pg8::Unit&, int, int, int, int) const { return NoPf{}; }
    __device__ __forceinline__ void operator()(AccRef acc, const pg8::Unit& u, int wr, int wc, int fr, int fq, const NoPf&) const {
        const int row0 = u.pm * 256 + wr * 64 + fr;
#pragma unroll
        for (int bj = 0; bj < 2; ++bj) {
            const int col = u.pn * 256 + bj * 128 + wc * 32 + 8 * fq, h = col / QKD, d = col - h * QKD;
#pragma unroll
            for (int ai = 0; ai < 2; ++ai)
#pragma unroll
                for (int m = 0; m < 4; ++m) {
                    const int row = row0 + ai * 128 + m * 16, b = row >> 12, s = row & (SEQ - 1);
                    const f32x4 s0 = *(const f32x4*)(ssp + (size_t)row * 20), s1 = *(const f32x4*)(ssp + (size_t)row * 20 + 4), s2 = *(const f32x4*)(ssp + (size_t)row * 20 + 8);
                    const float rs = rsqrtf((((s0[0] + s0[1]) + (s0[2] + s0[3])) + ((s1[0] + s1[1]) + (s1[2] + s1[3])) + ((s2[0] + s2[1]) + (s2[2] + s2[3]))) * (1.f / Q_LORA) + RMS_EPS);
                    f32x4 v0 = acc[ai][bj][m][0] * rs, v1 = acc[ai][bj][m][1] * rs;
                    if (d >= QK_NOPE) rope4(v0, v1, rope + (size_t)row * 64 + (d - QK_NOPE));
                    *(v4u*)(Q + ((size_t)((b * MLA_H + h) * SEQ + s)) * QKD + d) = pack8(v0, v1);
                }
        }
    }
};

struct EpiKVB {
    bf16* KN; bf16* V; const float* ssp;
    __device__ __forceinline__ NoPf prefetch(const pg8::Unit&, int, int, int, int) const { return NoPf{}; }
    __device__ __forceinline__ void operator()(AccRef acc, const pg8::Unit& u, int wr, int wc, int fr, int fq, const NoPf&) const {
        const int row0 = u.pm * 256 + wr * 64 + fr, d = wc * 32 + 8 * fq, h = u.pn;
#pragma unroll
        for (int ai = 0; ai < 2; ++ai)
#pragma unroll
            for (int m = 0; m < 4; ++m) {
                const int row = row0 + ai * 128 + m * 16, b = row >> 12, s = row & (SEQ - 1);
                const f32x4 s0 = *(const f32x4*)(ssp + (size_t)row * 20 + 12), s1 = *(const f32x4*)(ssp + (size_t)row * 20 + 16);
                const float rs = rsqrtf((((s0[0] + s0[1]) + (s0[2] + s0[3])) + ((s1[0] + s1[1]) + (s1[2] + s1[3]))) * (1.f / KV_LORA) + RMS_EPS);
                const size_t o = ((size_t)((b * MLA_H + h) * SEQ + s)) * 128 + d;
                *(v4u*)(KN + o) = pack8(acc[ai][0][m][0] * rs, acc[ai][0][m][1] * rs);
                *(v4u*)(V + o) = pack8(acc[ai][1][m][0] * rs, acc[ai][1][m][1] * rs);
            }
    }
};

struct EpiOut {
    const float* X; bf16* H; float* ss2p;
    __device__ __forceinline__ NoPf prefetch(const pg8::Unit&, int, int, int, int) const { return NoPf{}; }
    __device__ __forceinline__ void operator()(AccRef acc, const pg8::Unit& u, int wr, int wc, int fr, int fq, const NoPf&) const {
        const int row0 = u.pm * 256 + wr * 64 + fr, col0 = u.pn * 256 + wc * 32 + 8 * fq;
#pragma unroll
        for (int ai = 0; ai < 2; ++ai)
#pragma unroll
            for (int m = 0; m < 4; ++m) {
                const int row = row0 + ai * 128 + m * 16; float s = 0.f;
#pragma unroll
                for (int bj = 0; bj < 2; ++bj) {
                    const size_t o = (size_t)row * DM + col0 + bj * 128;
                    const f32x4 v0 = acc[ai][bj][m][0] + *(const f32x4*)(X + o), v1 = acc[ai][bj][m][1] + *(const f32x4*)(X + o + 4);
                    *(v4u*)(H + o) = pack8(v0, v1);
                    s += v0[0] * v0[0] + v0[1] * v0[1] + v0[2] * v0[2] + v0[3] * v0[3] + v1[0] * v1[0] + v1[1] * v1[1] + v1[2] * v1[2] + v1[3] * v1[3];
                }
                s += __shfl_xor(s, 16); s += __shfl_xor(s, 32); if (fq == 0) ss2p[(size_t)row * 32 + u.pn * 4 + wc] = s;
            }
    }
};

__device__ __forceinline__ float swiglu(float g, float l) {
    g = fminf(g, 7.f); l = fminf(fmaxf(l, -7.f), 7.f);
    return g * __builtin_amdgcn_rcpf(1.f + __expf(-1.702f * g)) * (l + 1.f);
}
__device__ __forceinline__ float sat8(float v) { return __builtin_amdgcn_fmed3f(v, -448.f, 448.f); }
__device__ __forceinline__ unsigned pk4_fp8(float a, float b, float c, float d) { int w = 0; w = __builtin_amdgcn_cvt_pk_fp8_f32(sat8(a), sat8(b), w, false); w = __builtin_amdgcn_cvt_pk_fp8_f32(sat8(c), sat8(d), w, true); return (unsigned)w; }
constexpr float W8_SCALE = 128.f, X8_SCALE = 16.f, A8_SCALE = 4.f;
static_assert(A8_SCALE == 4.f, "swiglu2 folds A8_SCALE = 4 into its last multiply");
__device__ __forceinline__ f32x2 swiglu2(f32x2 g, f32x2 l) {
    g = __builtin_elementwise_min(g, (f32x2){7.f, 7.f});
    l = __builtin_elementwise_min(__builtin_elementwise_max(l, (f32x2){-7.f, -7.f}), (f32x2){7.f, 7.f});
    const f32x2 t = g * (-1.702f * 1.4426950408889634f);
    f32x2 e; e[0] = __builtin_amdgcn_exp2f(t[0]); e[1] = __builtin_amdgcn_exp2f(t[1]);
    const f32x2 d = e + 1.f;
    f32x2 r; r[0] = __builtin_amdgcn_rcpf(d[0]); r[1] = __builtin_amdgcn_rcpf(d[1]);
    return (g * r) * (l * 4.f + 4.f);
}
struct EpiNull {
    unsigned char* D;
    __device__ __forceinline__ NoPf prefetch(const pg8::Unit&, int, int, int, int) const { return NoPf{}; }
    __device__ __forceinline__ void operator()(AccRef acc, const pg8::Unit& u, int wr, int wc, int fr, int fq, const NoPf&) const {
        f32x4 s = acc[0][0][0][0];
#pragma unroll
        for (int ai = 0; ai < 2; ++ai)
#pragma unroll
            for (int bj = 0; bj < 2; ++bj)
#pragma unroll
                for (int m = 0; m < 4; ++m) { s += acc[ai][bj][m][0]; s += acc[ai][bj][m][1]; }
        *(f32x4*)(D + ((size_t)(u.pm * 16 + u.pn) * 512 + threadIdx.x) * 16) = s; }
};
struct EpiGU {
    unsigned char* ACT; const float* bias;
    __device__ __forceinline__ BiasPf prefetch(const pg8::Unit& u, int wr, int wc, int fr, int fq) const { BiasPf p; const float* bp = bias + (size_t)u.e * 4096 + u.pn * 256 + wc * 64 + 16 * fq;
        asm volatile("global_load_dwordx4 %0, %4, off\n\tglobal_load_dwordx4 %1, %4, off offset:16\n\tglobal_load_dwordx4 %2, %4, off offset:32\n\tglobal_load_dwordx4 %3, %4, off offset:48"
                     : "=&v"(p.bv[0][0]), "=&v"(p.bv[0][1]), "=&v"(p.bv[1][0]), "=&v"(p.bv[1][1]) : "v"(bp) : "memory");
        return p; }
    __device__ __forceinline__ void operator()(AccRef acc, const pg8::Unit& u, int wr, int wc, int fr, int fq, const BiasPf& pfb) const {
        const int row0 = u.pm * 256 + wr * 64 + fr, col0 = u.pn * 256 + wc * 64 + 16 * fq;
        constexpr float SC = 1.f / (W8_SCALE * X8_SCALE);
        const auto& bv = pfb.bv;
#pragma unroll
        for (int ai = 0; ai < 2; ++ai)
#pragma unroll
            for (int m = 0; m < 4; ++m) {
                const int row = row0 + ai * 128 + m * 16; v2u w;
#pragma unroll
                for (int bj = 0; bj < 2; ++bj) {
                    const f32x4 v0 = acc[ai][bj][m][0] * SC + bv[bj][0], v1 = acc[ai][bj][m][1] * SC + bv[bj][1];
                    const f32x2 a = swiglu2((f32x2){v0[0], v0[2]}, (f32x2){v0[1], v0[3]}), b = swiglu2((f32x2){v1[0], v1[2]}, (f32x2){v1[1], v1[3]});
                    const unsigned q = pk4_fp8(a[0], a[1], b[0], b[1]); if (bj == 0) w.x = q; else w.y = q; }
                *(v2u*)(ACT + (size_t)row * DEXP + (col0 >> 1)) = w;
            }
    }
};
constexpr float Y8_SCALE = 16.f;
struct EpiDN {
    unsigned char* Y; const float* bias;
    __device__ __forceinline__ BiasPf prefetch(const pg8::Unit& u, int wr, int wc, int fr, int fq) const { BiasPf p; const float* bp = bias + (size_t)u.e * DM + u.pn * 256 + wc * 64 + 16 * fq;
        asm volatile("global_load_dwordx4 %0, %4, off\n\tglobal_load_dwordx4 %1, %4, off offset:16\n\tglobal_load_dwordx4 %2, %4, off offset:32\n\tglobal_load_dwordx4 %3, %4, off offset:48"
                     : "=&v"(p.bv[0][0]), "=&v"(p.bv[0][1]), "=&v"(p.bv[1][0]), "=&v"(p.bv[1][1]) : "v"(bp) : "memory");
        return p; }
    __device__ __forceinline__ void operator()(AccRef acc, const pg8::Unit& u, int wr, int wc, int fr, int fq, const BiasPf& pfb) const {
        const int row0 = u.pm * 256 + wr * 64 + fr, col0 = u.pn * 256 + wc * 64 + 16 * fq;
        const auto& bv = pfb.bv;
#pragma unroll
        for (int ai = 0; ai < 2; ++ai)
#pragma unroll
            for (int m = 0; m < 4; ++m) {
                const int row = row0 + ai * 128 + m * 16; v4u w;
#pragma unroll
                for (int bj = 0; bj < 2; ++bj) {
                    const f32x4 y0 = (acc[ai][bj][m][0] * (1.f / (W8_SCALE * A8_SCALE)) + bv[bj][0]) * Y8_SCALE, y1 = (acc[ai][bj][m][1] * (1.f / (W8_SCALE * A8_SCALE)) + bv[bj][1]) * Y8_SCALE;
                    const unsigned q0 = pk4_fp8(y0[0], y0[1], y0[2], y0[3]), q1 = pk4_fp8(y1[0], y1[1], y1[2], y1[3]);
                    if (bj == 0) { w.x = q0; w.y = q1; } else { w.z = q0; w.w = q1; } }
                *(v4u*)(Y + (size_t)row * DM + col0) = w;
            }
    }
};

template <int NPX>
struct MoeOrder {
    const char* A; const char* W; const LAS int* tile_e; size_t tstepA, tstepB, estep; int T, G8, x, q; const int* rtok = nullptr;
    __device__ void init(const void* A_, int lda, const void* W_, int ldb, size_t estep_bytes, const LAS int* te, int T_, int G, int c) {
        A = (const char*)A_; W = (const char*)W_; tile_e = te; tstepA = (size_t)256 * lda * 2; tstepB = (size_t)256 * ldb * 2; estep = estep_bytes; T = T_; G8 = G >> 3; x = c & 7; q = c >> 3; }
    __device__ bool next(int i, pg8::Unit& u) const {
        const int v = i * G8 + q, t = v / NPX, n = NPX * x + (v % NPX);
        if (t >= T) return false;
        const int e = __builtin_amdgcn_readfirstlane(tile_e[t]);
        u.pm = t; u.pn = n; u.e = e; u.A0 = rtok ? A : A + (size_t)t * tstepA; u.B0 = W + (size_t)e * estep + (size_t)n * tstepB; return true;
    }
    __device__ const int* rowtab(const pg8::Unit& u) const { return rtok + u.pm * 256; }
};

struct Frame {
    LAS unsigned char* lds;
    volatile LAS unsigned* MISC;
    gu32* ctl;
    int tid, lane, wave, G, c;
    unsigned char* ws;
    const float* in[26];
    float* out;
};
enum { I_X = 0, I_POS, I_NORM1, I_WIN, I_CONVW, I_CONVB, I_DTBF, I_DTBB, I_ALOGF, I_ALOGB, I_DSKIP, I_SSMNW, I_QANW, I_WQB, I_KVANW, I_WKVB, I_ATTNW, I_WOUT,
       I_NORM2, I_WR, I_BR, I_WGU, I_BGU, I_WDN, I_BDN, I_FNW };

template <class Map>
__device__ __forceinline__ void p0_transpose_item(const float* W, int N, bf16* WT, int ldt, const Map& map, const float* ks, LAS float* scr, int item, int lane) {
    const int nblk = N / 32, kb = item / nblk, nb = item % nblk, k0 = 64 * kb, n0 = 32 * nb, lr = lane >> 3, lq = lane & 7;
    f32x4 v[8];
#pragma unroll
    for (int i = 0; i < 8; ++i) v[i] = *(const f32x4*)(W + (size_t)(k0 + 8 * i + lr) * N + n0 + 4 * lq);
#pragma unroll
    for (int i = 0; i < 8; ++i) { const int k = 8 * i + lr; const float sc = ks ? ks[k0 + k] : 1.f; *(LAS f32x4*)(scr + k * 32 + 4 * (lq ^ ((k >> 3) & 7))) = v[i] * sc; }
    LDS_WAIT(); asm volatile("" ::: "memory");
    const int c = lq;
#pragma unroll
    for (int j = 0; j < 4; ++j) { const int n = lr + 8 * j; const LAS float* s = scr + (8 * c) * 32 + 4 * ((n >> 2) ^ c) + (n & 3);
        v4u o; o.x = cvt_pk_bf16(s[0 * 32], s[1 * 32]); o.y = cvt_pk_bf16(s[2 * 32], s[3 * 32]); o.z = cvt_pk_bf16(s[4 * 32], s[5 * 32]); o.w = cvt_pk_bf16(s[6 * 32], s[7 * 32]);
        *(v4u*)(WT + (size_t)map(n0 + n) * ldt + k0 + 8 * c) = o; }
    LDS_WAIT(); asm volatile("" ::: "memory");
}
__device__ __forceinline__ void p0_item_load(const float* W, int N, int item, int lane, f32x4 (&v)[8]) {
    const int nblk = N / 32, kb = item / nblk, nb = item % nblk, k0 = 64 * kb, n0 = 32 * nb, lr = lane >> 3, lq = lane & 7;
#pragma unroll
    for (int i = 0; i < 8; ++i) v[i] = __builtin_nontemporal_load((const f32x4*)(W + (size_t)(k0 + 8 * i + lr) * N + n0 + 4 * lq));
}
template <class Map>
__device__ __forceinline__ void p0_item_finish(const f32x4 (&v)[8], int N, bf16* WT, int ldt, const Map& map, LAS float* scr, int item, int lane) {
    const int nblk = N / 32, kb = item / nblk, nb = item % nblk, k0 = 64 * kb, n0 = 32 * nb, lr = lane >> 3, lq = lane & 7;
#pragma unroll
    for (int i = 0; i < 8; ++i) { const int k = 8 * i + lr; *(LAS f32x4*)(scr + k * 32 + 4 * (lq ^ ((k >> 3) & 7))) = v[i]; }
    LDS_WAIT(); asm volatile("" ::: "memory");
    const int c = lq;
#pragma unroll
    for (int j = 0; j < 4; ++j) { const int n = lr + 8 * j; const LAS float* s = scr + (8 * c) * 32 + 4 * ((n >> 2) ^ c) + (n & 3);
        v4u o; o.x = cvt_pk_bf16(s[0 * 32], s[1 * 32]); o.y = cvt_pk_bf16(s[2 * 32], s[3 * 32]); o.z = cvt_pk_bf16(s[4 * 32], s[5 * 32]); o.w = cvt_pk_bf16(s[6 * 32], s[7 * 32]);
        *(v4u*)(WT + (size_t)map(n0 + n) * ldt + k0 + 8 * c) = o; }
    LDS_WAIT(); asm volatile("" ::: "memory");
}
__device__ __forceinline__ void p0_transpose_item_fp8(const float* W, int N, unsigned char* WT, int ldt, float sc, LAS float* scr, int item, int lane) {
    const int nblk = N / 32, kb = item / nblk, nb = item % nblk, k0 = 128 * kb, n0 = 32 * nb, lr = lane >> 3, lq = lane & 7;
    f32x4 v[16];
#pragma unroll
    for (int i = 0; i < 16; ++i) v[i] = __builtin_nontemporal_load((const f32x4*)(W + (size_t)(k0 + 8 * i + lr) * N + n0 + 4 * lq));
#pragma unroll
    for (int i = 0; i < 16; ++i) { const int k = 8 * i + lr; *(LAS f32x4*)(scr + k * 32 + 4 * (lq ^ ((k >> 4) & 7))) = v[i] * sc; }
    LDS_WAIT(); asm volatile("" ::: "memory");
    const int c = lq;
#pragma unroll
    for (int j = 0; j < 4; ++j) { const int n = lr + 8 * j; const LAS float* s = scr + (16 * c) * 32 + 4 * ((n >> 2) ^ c) + (n & 3);
        v4u o; o.x = pk4_fp8(s[0 * 32], s[1 * 32], s[2 * 32], s[3 * 32]); o.y = pk4_fp8(s[4 * 32], s[5 * 32], s[6 * 32], s[7 * 32]);
        o.z = pk4_fp8(s[8 * 32], s[9 * 32], s[10 * 32], s[11 * 32]); o.w = pk4_fp8(s[12 * 32], s[13 * 32], s[14 * 32], s[15 * 32]);
        __builtin_nontemporal_store(o, (v4u*)(WT + (size_t)(n0 + n) * ldt + k0 + 16 * c)); }
    LDS_WAIT(); asm volatile("" ::: "memory");
}
struct MapId { int off; __device__ int operator()(int n) const { return n + off; } };
struct MapIn { __device__ int operator()(int n) const {
    if (n < 2560) return n;
    if (n < 2592) return 3904 + (n - 2560);
    if (n < 3360) return PC_QA + (n - 2592);
    if (n < 3872) return PC_KVA + (n - 3360);
    const int j = n - 3872; return 3840 + ((j & 31) << 1) + (j >> 5); } };
struct MapQB { __device__ int operator()(int n) const { const int h = n / QKD, d = n - h * QKD; if (d < QK_NOPE) return n; const int j = d - QK_NOPE; return h * QKD + QK_NOPE + ((j & 31) << 1) + (j >> 5); } };

__device__ __forceinline__ void p0_prologue(Frame& F) {
    LAS float* scr = (LAS float*)(F.lds + F.wave * 16384);
    const int gw = F.c * NWAVES + F.wave, NGW = F.G * NWAVES, lane = F.lane;
    unsigned char* ws = F.ws;
    { const int* pos = (const int*)F.in[I_POS]; float* rope = (float*)(ws + WS_ROPE);
      for (int i = gw * 64 + lane; i < NT * 32; i += NGW * 64) { const int t = i >> 5, j = i & 31;
          const float inv = powf(10000.f, -(float)(2 * j) / 64.f); const float ang = (float)pos[t] * inv; float sn, cs; sincosf(ang, &sn, &cs); rope[2 * i] = cs; rope[2 * i + 1] = sn; } }
    { bf16* wh = (bf16*)(ws + WS_WRT); bf16* wl = wh + NEXP * DM; const float* wr = F.in[I_WR]; const float* n2 = F.in[I_NORM2];
      for (int i = gw * 64 + lane; i < NEXP * DM; i += NGW * 64) { const int e = i >> 11, k = i & (DM - 1); const float w = wr[(size_t)k * NEXP + e] * n2[k];
          const unsigned h = cvt_pk_bf16(w, 0.f) & 0xffffu; const float r = w - bf_lo(h); wh[i] = (bf16)h; wl[i] = (bf16)(cvt_pk_bf16(r, 0.f) & 0xffffu); } }
    { v4u* pad = (v4u*)(ws + WS_WIN + (size_t)IN_PROJ * DM * 2); const int n16 = (NIN_PAD - IN_PROJ) * DM * 2 / 16;
      for (int i = gw * 64 + lane; i < n16; i += NGW * 64) pad[i] = (v4u){0u, 0u, 0u, 0u}; }
    constexpr int I_IN = (DM / 64) * (IN_PROJ / 32);
    { const float* x = F.in[I_X]; const float* w = F.in[I_NORM1]; bf16* xn = (bf16*)(ws + WS_XN);
      f32x4 wv[8]; int wit = gw; bool wpend = wit < I_IN;
      if (wpend) p0_item_load(F.in[I_WIN], IN_PROJ, wit, lane, wv);
      for (int m = 2 * gw; m < NT; m += 2 * NGW) {
          const f32x4* xr = (const f32x4*)(x + (size_t)m * DM) + lane; f32x4 v[2][8]; float s0 = 0.f, s1 = 0.f;
#pragma unroll
          for (int j = 0; j < 8; ++j) { v[0][j] = __builtin_nontemporal_load(xr + 64 * j); v[1][j] = __builtin_nontemporal_load(xr + DM / 4 + 64 * j); }
#pragma unroll
          for (int j = 0; j < 8; ++j) { s0 += v[0][j][0] * v[0][j][0] + v[0][j][1] * v[0][j][1] + v[0][j][2] * v[0][j][2] + v[0][j][3] * v[0][j][3];
                                        s1 += v[1][j][0] * v[1][j][0] + v[1][j][1] * v[1][j][1] + v[1][j][2] * v[1][j][2] + v[1][j][3] * v[1][j][3]; }
          const float rs0 = rsqrtf(wave_sum(s0) * (1.f / DM) + RMS_EPS), rs1 = rsqrtf(wave_sum(s1) * (1.f / DM) + RMS_EPS);
#pragma unroll
          for (int j = 0; j < 8; ++j) { const f32x4 g = *((const f32x4*)w + lane + 64 * j);
              v2u o; o.x = cvt_pk_bf16(v[0][j][0] * rs0 * g[0], v[0][j][1] * rs0 * g[1]); o.y = cvt_pk_bf16(v[0][j][2] * rs0 * g[2], v[0][j][3] * rs0 * g[3]);
              *((v2u*)(xn + (size_t)m * DM) + lane + 64 * j) = o;
              v2u p; p.x = cvt_pk_bf16(v[1][j][0] * rs1 * g[0], v[1][j][1] * rs1 * g[1]); p.y = cvt_pk_bf16(v[1][j][2] * rs1 * g[2], v[1][j][3] * rs1 * g[3]);
              *((v2u*)(xn + (size_t)(m + 1) * DM) + lane + 64 * j) = p; }
          if (wpend) { p0_item_finish(wv, IN_PROJ, (bf16*)(ws + WS_WIN), DM, MapIn{}, scr, wit, lane); wit += NGW; wpend = wit < I_IN; if (wpend) p0_item_load(F.in[I_WIN], IN_PROJ, wit, lane, wv); } }
      while (wpend) { p0_item_finish(wv, IN_PROJ, (bf16*)(ws + WS_WIN), DM, MapIn{}, scr, wit, lane); wit += NGW; wpend = wit < I_IN; if (wpend) p0_item_load(F.in[I_WIN], IN_PROJ, wit, lane, wv); } }
}
__device__ __forceinline__ void dense_weights_tail(Frame& F, int start, int stride) {
    LAS float* scr = (LAS float*)(F.lds + F.wave * 16384);
    const int lane = F.lane;
    unsigned char* ws = F.ws;
    constexpr int I_QB = (Q_LORA / 64) * (1536 / 32), I_KVB = (KV_LORA / 64) * (2048 / 32), I_OUT = (DM / 64) * (DM / 32);
    constexpr int NITEMS = I_QB + I_KVB + I_OUT;
    for (int it = start; it < NITEMS; it += stride) {
        int r = it;
        if (r < I_QB) { p0_transpose_item(F.in[I_WQB], 1536, (bf16*)(ws + WS_WQB), Q_LORA, MapQB{}, F.in[I_QANW], scr, r, lane); continue; } r -= I_QB;
        if (r < I_KVB) { p0_transpose_item(F.in[I_WKVB], 2048, (bf16*)(ws + WS_WKVB), KV_LORA, MapId{0}, F.in[I_KVANW], scr, r, lane); continue; } r -= I_KVB;
        if (r < I_OUT) { const int kb = r / (DM / 32);
            const float* ks = (kb < 16) ? F.in[I_SSMNW] : (F.in[I_ATTNW] - D_SSM);
            p0_transpose_item(F.in[I_WOUT], DM, (bf16*)(ws + WS_WOUT), DM, MapId{0}, ks, scr, r, lane); continue; } r -= I_OUT;
    }
}
constexpr int MOE_NIT = NEXP * ((DM / 128) * (4096 / 32) + (DEXP / 128) * (DM / 32));
constexpr int MOE_PRE1 = 7168, MOE_PRE2 = 4096;
__device__ __forceinline__ void moe_convert_range(Frame& F, int lo, int hi, int start, int stride) {
    LAS float* scr = (LAS float*)(F.lds + F.wave * 16384);
    const int lane = F.lane;
    unsigned char* ws = F.ws;
    constexpr int I_GU1 = (DM / 128) * (4096 / 32), I_DN1 = (DEXP / 128) * (DM / 32);
    __syncthreads();
    for (int it = lo + start; it < hi; it += stride) {
        int r = it;
        if (r < NEXP * I_GU1) { const int e = r / I_GU1, q = r % I_GU1;
            p0_transpose_item_fp8(F.in[I_WGU] + (size_t)e * DM * 4096, 4096, ws + WS_WGU + (size_t)e * 4096 * DM, DM, W8_SCALE, scr, q, lane); continue; } r -= NEXP * I_GU1;
        { const int e = r / I_DN1, q = r % I_DN1;
            p0_transpose_item_fp8(F.in[I_WDN] + (size_t)e * DEXP * DM, DM, ws + WS_WDN + (size_t)e * DM * DEXP, DEXP, W8_SCALE, scr, q, lane); }
    }
    __syncthreads();
}

template <int NTOK>
__device__ __forceinline__ void conv8(const bf16* Pcol, int s0, const float* cw, const float* cb, float (&out)[NTOK][8]) {
    float w[5][8], bias[8];
#pragma unroll
    for (int j = 0; j < 5; ++j) { const f32x4 a = *(const f32x4*)(cw + j * CONV_DIM), b = *(const f32x4*)(cw + j * CONV_DIM + 4);
        w[j][0] = a[0]; w[j][1] = a[1]; w[j][2] = a[2]; w[j][3] = a[3]; w[j][4] = b[0]; w[j][5] = b[1]; w[j][6] = b[2]; w[j][7] = b[3]; }
    { const f32x4 a = *(const f32x4*)cb, b = *(const f32x4*)(cb + 4); bias[0] = a[0]; bias[1] = a[1]; bias[2] = a[2]; bias[3] = a[3]; bias[4] = b[0]; bias[5] = b[1]; bias[6] = b[2]; bias[7] = b[3]; }
#pragma unroll
    for (int t = 0; t < NTOK; ++t)
#pragma unroll
        for (int c = 0; c < 8; ++c) out[t][c] = bias[c];
#pragma unroll
    for (int r = 0; r < NTOK + 4; ++r) {
        const int s = s0 - 2 + r, sc = s < 0 ? 0 : (s > SEQ - 1 ? SEQ - 1 : s); const float msk = (s == sc) ? 1.f : 0.f;
        const v4u raw = *(const v4u*)(Pcol + (size_t)sc * NPROJ);
        float v[8]; v[0] = bf_lo(raw.x) * msk; v[1] = bf_hi(raw.x) * msk; v[2] = bf_lo(raw.y) * msk; v[3] = bf_hi(raw.y) * msk; v[4] = bf_lo(raw.z) * msk; v[5] = bf_hi(raw.z) * msk; v[6] = bf_lo(raw.w) * msk; v[7] = bf_hi(raw.w) * msk;
#pragma unroll
        for (int j = 0; j < 5; ++j) { const int t = r - j; if (t >= 0 && t < NTOK) {
#pragma unroll
            for (int c = 0; c < 8; ++c) out[t][c] += w[j][c] * v[c]; } }
    }
#pragma unroll
    for (int t = 0; t < NTOK; ++t)
#pragma unroll
        for (int c = 0; c < 8; ++c) out[t][c] = silu_f(out[t][c]);
}
__device__ __forceinline__ float softplus_f(float x) { return x > 20.f ? x : log1pf(__expf(x)); }

__device__ __forceinline__ void ssd_local_unit(Frame& F, int unit) {
    const int half = unit & 1, g = (unit >> 1) & 1, cc = (unit >> 2) & (NCHUNK - 1), b = unit >> 7;
    const int lane = F.lane, w = F.wave, hl = w >> 1, d = w & 1, h = g * 8 + half * 4 + hl;
    const int t0 = b * SEQ + cc * CHUNK;
    unsigned char* ws = F.ws;
    const bf16* PROJ = (const bf16*)(ws + WS_PROJ) + (size_t)b * SEQ * NPROJ;
    const float* cw = F.in[I_CONVW]; const float* cb = F.in[I_CONVB];
    LAS unsigned char* XT = F.lds;
    LAS unsigned char* BT = F.lds + 65536;
    LAS float* WARR = (LAS float*)(F.lds + 98304) + w * 128;
    __syncthreads();
    { const int cg = lane & 7, ts = lane >> 3, ch = h * 64 + 8 * cg, sl = 64 * d + 8 * ts; float o[8][8];
      conv8<8>(PROJ + PC_XS + ch, cc * CHUNK + sl, cw + ch, cb + ch, o);
      bf16* xtg = (bf16*)(ws + WS_XT) + ((size_t)((b * NCHUNK + cc) * SSM_HEADS + h)) * 8192;
#pragma unroll
      for (int c = 0; c < 8; ++c) { const int p = 8 * cg + c, oc = 8 * d + ts;
          v4u pk; pk.x = cvt_pk_bf16(o[0][c], o[1][c]); pk.y = cvt_pk_bf16(o[2][c], o[3][c]); pk.z = cvt_pk_bf16(o[4][c], o[5][c]); pk.w = cvt_pk_bf16(o[6][c], o[7][c]);
          *(LAS v4u*)(XT + hl * 16384 + p * 256 + ((oc ^ (p & 15)) << 4)) = pk;
          *(v4u*)(xtg + p * 128 + sl) = pk; } }
    { const int cg = lane & 15, ts = lane >> 4, n0 = 8 * cg, sl = 16 * w + 4 * ts; float o[4][8];
      conv8<4>(PROJ + PC_B + g * 128 + n0, cc * CHUNK + sl, cw + 1024 + g * 128 + n0, cb + 1024 + g * 128 + n0, o);
#pragma unroll
      for (int c = 0; c < 8; ++c) { const int n = n0 + c, oc = sl >> 3; v2u pk; pk.x = cvt_pk_bf16(o[0][c], o[1][c]); pk.y = cvt_pk_bf16(o[2][c], o[3][c]);
          *(LAS v2u*)(BT + n * 256 + ((oc ^ (n & 15)) << 4) + (ts & 1) * 8) = pk; }
      if (half == 0) { bf16* bcg = (bf16*)(ws + WS_BC) + (size_t)(t0 + sl) * 512 + g * 128 + n0;
#pragma unroll
          for (int t = 0; t < 4; ++t) { v4u pk; pk.x = cvt_pk_bf16(o[t][0], o[t][1]); pk.y = cvt_pk_bf16(o[t][2], o[t][3]); pk.z = cvt_pk_bf16(o[t][4], o[t][5]); pk.w = cvt_pk_bf16(o[t][6], o[t][7]);
              *(v4u*)(bcg + (size_t)t * 512) = pk; } } }
    { const int cg = lane & 15, ts = lane >> 4, n0 = 8 * cg, sl = 64 * half + 8 * w + 2 * ts; float o[2][8];
      conv8<2>(PROJ + PC_C + g * 128 + n0, cc * CHUNK + sl, cw + 1280 + g * 128 + n0, cb + 1280 + g * 128 + n0, o);
      bf16* bcg = (bf16*)(ws + WS_BC) + (size_t)(t0 + sl) * 512 + 256 + g * 128 + n0;
#pragma unroll
      for (int t = 0; t < 2; ++t) { v4u pk; pk.x = cvt_pk_bf16(o[t][0], o[t][1]); pk.y = cvt_pk_bf16(o[t][2], o[t][3]); pk.z = cvt_pk_bf16(o[t][4], o[t][5]); pk.w = cvt_pk_bf16(o[t][6], o[t][7]);
          *(v4u*)(bcg + (size_t)t * 512) = pk; } }
    float total;
    { const float* DT = (const float*)(ws + WS_DT); const float bias = (d ? F.in[I_DTBB] : F.in[I_DTBF])[h]; const float A = -__expf((d ? F.in[I_ALOGB] : F.in[I_ALOGF])[h]);
      const float dt0 = softplus_f(DT[(size_t)(t0 + lane) * 32 + 16 * d + h] + bias), dt1 = softplus_f(DT[(size_t)(t0 + lane + 64) * 32 + 16 * d + h] + bias);
      const float a0 = dt0 * A, a1 = dt1 * A; float c0 = a0, c1 = a1;
#pragma unroll
      for (int o = 1; o < 64; o <<= 1) { const float u0 = __shfl_up(c0, o), u1 = __shfl_up(c1, o); if (lane >= o) { c0 += u0; c1 += u1; } }
      const float tot0 = __shfl(c0, 63); c1 += tot0; total = __shfl(c1, 63);
      const float X0 = d ? (total - c0 + a0) : c0, X1 = d ? (total - c1 + a1) : c1;
      WARR[lane] = dt0 * __expf(total - X0); WARR[lane + 64] = dt1 * __expf(total - X1);
      float* dta = (float*)(ws + WS_DTA);
      *(f32x2*)(dta + (size_t)(t0 + lane) * 64 + h * 4 + 2 * d) = (f32x2){dt0, X0};
      *(f32x2*)(dta + (size_t)(t0 + lane + 64) * 64 + h * 4 + 2 * d) = (f32x2){dt1, X1};
      if (lane == 0) ((float*)(ws + WS_CD))[((size_t)(b * NCHUNK + cc) * SSM_HEADS + h) * 2 + d] = __expf(total); }
    __syncthreads();
    { const int fr = lane & 15, fq = lane >> 4;
      bf16* st = (bf16*)(ws + WS_ST) + ((size_t)(((b * NCHUNK + cc) * SSM_HEADS + h) * 2 + d)) * 8192;
#pragma unroll 1
      for (int ih = 0; ih < 2; ++ih) {
          f32x4 acc[4][4];
#pragma unroll
          for (int i = 0; i < 4; ++i)
#pragma unroll
              for (int j = 0; j < 4; ++j) acc[i][j] = (f32x4){0.f, 0.f, 0.f, 0.f};
#pragma unroll
          for (int ks = 0; ks < 4; ++ks) { const int oc = 4 * ks + fq;
              const f32x4 w0 = *(const LAS f32x4*)(WARR + 8 * oc), w1 = *(const LAS f32x4*)(WARR + 8 * oc + 4);
              bf16x8 bfr[4];
#pragma unroll
              for (int j = 0; j < 4; ++j) { const int p = 16 * j + fr; const v4u raw = *(const LAS v4u*)(XT + hl * 16384 + p * 256 + ((oc ^ (p & 15)) << 4));
                  v4u sc; sc.x = cvt_pk_bf16(bf_lo(raw.x) * w0[0], bf_hi(raw.x) * w0[1]); sc.y = cvt_pk_bf16(bf_lo(raw.y) * w0[2], bf_hi(raw.y) * w0[3]);
                  sc.z = cvt_pk_bf16(bf_lo(raw.z) * w1[0], bf_hi(raw.z) * w1[1]); sc.w = cvt_pk_bf16(bf_lo(raw.w) * w1[2], bf_hi(raw.w) * w1[3]);
                  bfr[j] = __builtin_bit_cast(bf16x8, sc); }
#pragma unroll
              for (int i = 0; i < 4; ++i) { const int n = 16 * (4 * ih + i) + fr; const bf16x8 afr = *(const LAS bf16x8*)(BT + n * 256 + ((oc ^ (n & 15)) << 4));
#pragma unroll
                  for (int j = 0; j < 4; ++j) acc[i][j] = __builtin_amdgcn_mfma_f32_16x16x32_bf16(afr, bfr[j], acc[i][j], 0, 0, 0); }
          }
#pragma unroll
          for (int i = 0; i < 4; ++i)
#pragma unroll
              for (int j = 0; j < 4; ++j) { v2u pk; pk.x = cvt_pk_bf16(acc[i][j][0], acc[i][j][1]); pk.y = cvt_pk_bf16(acc[i][j][2], acc[i][j][3]); *(v2u*)(st + (16 * j + fr) * 128 + 16 * (4 * ih + i) + 4 * fq) = pk; }
      }
    }
}

__device__ __forceinline__ void ssd_scan_item(Frame& F, int item) {
    const int hf = item & 1, d = (item >> 1) & 1, h = (item >> 2) & 15, b = item >> 6;
    bf16* st = (bf16*)(F.ws + WS_ST); const float* cd = (const float*)(F.ws + WS_CD);
    const size_t i0 = (size_t)(b * NCHUNK * SSM_HEADS + h) * 2 + d;
    v4u* p0 = (v4u*)(st + i0 * 8192 + hf * 4096) + F.tid;
    constexpr size_t CS = (size_t)SSM_HEADS * 2 * 8192 / 8;
    float carry[8];
#pragma unroll
    for (int q = 0; q < 8; ++q) carry[q] = 0.f;
#pragma unroll 1
    for (int half = 0; half < 2; ++half) {
        v4u v[16];
#pragma unroll
        for (int j = 0; j < 16; ++j) { const int cc = d ? (NCHUNK - 1 - (16 * half + j)) : (16 * half + j); v[j] = p0[(size_t)cc * CS]; }
#pragma unroll
        for (int j = 0; j < 16; ++j) { const int cc = d ? (NCHUNK - 1 - (16 * half + j)) : (16 * half + j); const float dec = cd[i0 + (size_t)cc * SSM_HEADS * 2];
            v4u o; o.x = cvt_pk_bf16(carry[0], carry[1]); o.y = cvt_pk_bf16(carry[2], carry[3]); o.z = cvt_pk_bf16(carry[4], carry[5]); o.w = cvt_pk_bf16(carry[6], carry[7]);
            p0[(size_t)cc * CS] = o;
            carry[0] = carry[0] * dec + bf_lo(v[j].x); carry[1] = carry[1] * dec + bf_hi(v[j].x); carry[2] = carry[2] * dec + bf_lo(v[j].y); carry[3] = carry[3] * dec + bf_hi(v[j].y);
            carry[4] = carry[4] * dec + bf_lo(v[j].z); carry[5] = carry[5] * dec + bf_hi(v[j].z); carry[6] = carry[6] * dec + bf_lo(v[j].w); carry[7] = carry[7] * dec + bf_hi(v[j].w); }
    }
}

__device__ __forceinline__ void ssd_out_unit(Frame& F, int unit) {
    const int g = unit & 1, cc = (unit >> 1) & (NCHUNK - 1), b = unit >> 6;
    int lane = F.lane; asm volatile("" : "+v"(lane));
    const int w = F.wave, h = g * 8 + w, fr = lane & 15, fq = lane >> 4;
    const int t0 = b * SEQ + cc * CHUNK;
    unsigned char* ws = F.ws;
    const bf16* BC = (const bf16*)(ws + WS_BC) + (size_t)t0 * 512;
    LAS unsigned char* CB = F.lds;
    LAS f32x4* AR = (LAS f32x4*)(F.lds + 32768) + w * 128;
    LAS float* SSQ = (LAS float*)(F.lds + 49152);
    LAS unsigned char* CT = F.lds + 65536;
    __syncthreads();
    { f32x4 acc[8];
#pragma unroll
      for (int i = 0; i < 8; ++i) acc[i] = (f32x4){0.f, 0.f, 0.f, 0.f};
#pragma unroll
      for (int ks = 0; ks < 4; ++ks) { const int n0 = 32 * ks + 8 * fq;
          const bf16x8 cf = *(const bf16x8*)(BC + (size_t)(16 * w + fr) * 512 + 256 + g * 128 + n0);
          { const int l = 16 * w + fr; *(LAS bf16x8*)(CT + l * 256 + (((4 * ks + fq) ^ (l & 15)) << 4)) = cf; }
#pragma unroll
          for (int i = 0; i < 8; ++i) { const bf16x8 bfg = *(const bf16x8*)(BC + (size_t)(16 * i + fr) * 512 + g * 128 + n0);
              acc[i] = __builtin_amdgcn_mfma_f32_16x16x32_bf16(bfg, cf, acc[i], 0, 0, 0); } }
      const int l = 16 * w + fr;
#pragma unroll
      for (int i = 0; i < 8; ++i) { const int oc = 2 * i + (fq >> 1); v2u pk; pk.x = cvt_pk_bf16(acc[i][0], acc[i][1]); pk.y = cvt_pk_bf16(acc[i][2], acc[i][3]);
          *(LAS v2u*)(CB + l * 256 + ((oc ^ (l & 15)) << 4) + (fq & 1) * 8) = pk; } }
    { const f32x4* dta = (const f32x4*)(ws + WS_DTA); AR[lane] = dta[(size_t)(t0 + lane) * 16 + h]; AR[lane + 64] = dta[(size_t)(t0 + lane + 64) * 16 + h]; }
    __syncthreads();
    const float dsk = F.in[I_DSKIP][h];
    const bf16* xtg = (const bf16*)(ws + WS_XT) + ((size_t)((b * NCHUNK + cc) * SSM_HEADS + h)) * 8192;
    const bf16* Z = (const bf16*)(ws + WS_PROJ) + (size_t)t0 * NPROJ + PC_Z + h * 64;
    bf16* YC = (bf16*)(ws + WS_YCAT) + (size_t)t0 * DM + h * 64;
#pragma unroll 1
    for (int hf = 0; hf < 2; ++hf) {
        f32x4 acc[4][4];
#pragma unroll
        for (int pt = 0; pt < 4; ++pt)
#pragma unroll
            for (int lt = 0; lt < 4; ++lt) acc[pt][lt] = (f32x4){0.f, 0.f, 0.f, 0.f};
        int fro = fr; asm volatile("" : "+v"(fro));
        const bf16* pv0 = (const bf16*)(ws + WS_ST) + ((size_t)(((b * NCHUNK + cc) * SSM_HEADS + h) * 2)) * 8192 + fro * 128 + 8 * fq;
        bf16x8 pq[3][4];
#define SSD_PQ(it) do { _Pragma("unroll") for (int q = 0; q < 4; ++q) pq[(it) % 3][q] = *(const bf16x8*)(pv0 + ((it) >> 2) * 8192 + (16 * q) * 128 + 32 * ((it) & 3)); } while (0)
        bf16x8 xfn[4];
#pragma unroll
        for (int pt = 0; pt < 4; ++pt) xfn[pt] = *(const bf16x8*)(xtg + (16 * pt + fro) * 128 + 8 * fq);
#pragma unroll 1
        for (int ks = 0; ks < 4; ++ks) { const int s0 = 32 * ks + 8 * fq;
            bf16x8 xf[4];
#pragma unroll
            for (int pt = 0; pt < 4; ++pt) xf[pt] = xfn[pt];
            if (ks < 3) {
#pragma unroll
                for (int pt = 0; pt < 4; ++pt) xfn[pt] = *(const bf16x8*)(xtg + (16 * pt + fro) * 128 + s0 + 32); }
            f32x4 as[8];
#pragma unroll
            for (int e = 0; e < 8; ++e) as[e] = AR[s0 + e];
#pragma unroll
            for (int lt = 0; lt < 4; ++lt) { const int l = 16 * (4 * hf + lt) + fr; const f32x4 al = AR[l];
                const v4u raw = *(const LAS v4u*)(CB + l * 256 + (((4 * ks + fq) ^ (l & 15)) << 4));
                float cbv[8]; cbv[0] = bf_lo(raw.x); cbv[1] = bf_hi(raw.x); cbv[2] = bf_lo(raw.y); cbv[3] = bf_hi(raw.y); cbv[4] = bf_lo(raw.z); cbv[5] = bf_hi(raw.z); cbv[6] = bf_lo(raw.w); cbv[7] = bf_hi(raw.w);
                float sv[8];
                const int rel = 16 * (4 * hf + lt) - 32 * ks;
                if (rel >= 32) {
#pragma unroll
                    for (int e = 0; e < 8; ++e) sv[e] = cbv[e] * (as[e][0] * __expf(al[1] - as[e][1]));
                } else if (rel <= -16) {
#pragma unroll
                    for (int e = 0; e < 8; ++e) sv[e] = cbv[e] * (as[e][2] * __expf(al[3] - as[e][3]));
                } else {
#pragma unroll
                    for (int e = 0; e < 8; ++e) { const int s = s0 + e; const bool lo = s < l, eq = s == l;
                        const float arg = lo ? (al[1] - as[e][1]) : (al[3] - as[e][3]);
                        float wgt = (lo ? as[e][0] : as[e][2]) * __expf(arg);
                        wgt += eq ? as[e][0] : 0.f;
                        sv[e] = cbv[e] * wgt + (eq ? dsk : 0.f); }
                }
                v4u pk; pk.x = cvt_pk_bf16(sv[0], sv[1]); pk.y = cvt_pk_bf16(sv[2], sv[3]); pk.z = cvt_pk_bf16(sv[4], sv[5]); pk.w = cvt_pk_bf16(sv[6], sv[7]);
                const bf16x8 sf = __builtin_bit_cast(bf16x8, pk);
#pragma unroll
                for (int pt = 0; pt < 4; ++pt) acc[pt][lt] = __builtin_amdgcn_mfma_f32_16x16x32_bf16(xf[pt], sf, acc[pt][lt], 0, 0, 0); }
        }
        SSD_PQ(0); SSD_PQ(1);
        v2u zr[4][4];
#pragma unroll
        for (int lt = 0; lt < 4; ++lt)
#pragma unroll
            for (int pt = 0; pt < 4; ++pt) zr[lt][pt] = *(const v2u*)(Z + (size_t)(16 * (4 * hf + lt) + fro) * NPROJ + 16 * pt + 4 * fq);
        { float ef[4], eb[4];
#pragma unroll
          for (int lt = 0; lt < 4; ++lt) { const f32x4 al = AR[16 * (4 * hf + lt) + fr]; ef[lt] = __expf(al[1]); eb[lt] = __expf(al[3]); }
#pragma unroll
          for (int it = 0; it < 8; ++it) {
              if (it + 2 < 8) SSD_PQ(it + 2);
              __builtin_amdgcn_sched_barrier(0);
#pragma unroll
              for (int lt = 0; lt < 4; ++lt) { const int l = 16 * (4 * hf + lt) + fr; const float e = (it >> 2) ? eb[lt] : ef[lt];
                  const v4u raw = *(const LAS v4u*)(CT + l * 256 + (((4 * (it & 3) + fq) ^ (l & 15)) << 4));
                  v4u pk; pk.x = cvt_pk_bf16(bf_lo(raw.x) * e, bf_hi(raw.x) * e); pk.y = cvt_pk_bf16(bf_lo(raw.y) * e, bf_hi(raw.y) * e); pk.z = cvt_pk_bf16(bf_lo(raw.z) * e, bf_hi(raw.z) * e); pk.w = cvt_pk_bf16(bf_lo(raw.w) * e, bf_hi(raw.w) * e);
                  const bf16x8 cf = __builtin_bit_cast(bf16x8, pk);
#pragma unroll
                  for (int pt = 0; pt < 4; ++pt) acc[pt][lt] = __builtin_amdgcn_mfma_f32_16x16x32_bf16(pq[it % 3][pt], cf, acc[pt][lt], 0, 0, 0); }
              __builtin_amdgcn_sched_barrier(0);
          } }
#undef SSD_PQ
#pragma unroll
        for (int lt = 0; lt < 4; ++lt) { const int l = 16 * (4 * hf + lt) + fr; float s = 0.f;
#pragma unroll
            for (int pt = 0; pt < 4; ++pt) { const v2u zv = zr[lt][pt];
                f32x4 y = acc[pt][lt]; y[0] *= silu_f(bf_lo(zv.x)); y[1] *= silu_f(bf_hi(zv.x)); y[2] *= silu_f(bf_lo(zv.y)); y[3] *= silu_f(bf_hi(zv.y)); acc[pt][lt] = y;
                s += y[0] * y[0] + y[1] * y[1] + y[2] * y[2] + y[3] * y[3]; }
            s += __shfl_xor(s, 16); s += __shfl_xor(s, 32);
            if (fq == 0) SSQ[l * 8 + w] = s; }
        __syncthreads();
#pragma unroll
        for (int lt = 0; lt < 4; ++lt) { const int l = 16 * (4 * hf + lt) + fr; const f32x4 a = *(const LAS f32x4*)(SSQ + l * 8), c = *(const LAS f32x4*)(SSQ + l * 8 + 4);
            float rs = rsqrtf((a[0] + a[1] + a[2] + a[3] + c[0] + c[1] + c[2] + c[3]) * (1.f / 512.f) + RMS_EPS);
            if (DBG_NO_SSM) rs = 0.f;
#pragma unroll
            for (int pt = 0; pt < 4; ++pt) { const f32x4 y = acc[pt][lt] * rs; v2u pk; pk.x = cvt_pk_bf16(y[0], y[1]); pk.y = cvt_pk_bf16(y[2], y[3]);
                *(v2u*)(YC + (size_t)l * DM + 16 * pt + 4 * fq) = pk; } }
    }
}

__device__ __forceinline__ void att_norm_rows(Frame& F) {
    const int gw = F.c * NWAVES + F.wave, NGW = F.G * NWAVES, lane = F.lane;
    const bf16* O = (const bf16*)(F.ws + WS_O); bf16* YC = (bf16*)(F.ws + WS_YCAT);
    for (int m = gw; m < NT; m += NGW) { const v4u r = *((const v4u*)(O + (size_t)m * 1024) + lane);
        const v4u r2 = *((const v4u*)(O + (size_t)m * 1024) + lane + 64);
        float v[16]; v[0] = bf_lo(r.x); v[1] = bf_hi(r.x); v[2] = bf_lo(r.y); v[3] = bf_hi(r.y); v[4] = bf_lo(r.z); v[5] = bf_hi(r.z); v[6] = bf_lo(r.w); v[7] = bf_hi(r.w);
        v[8] = bf_lo(r2.x); v[9] = bf_hi(r2.x); v[10] = bf_lo(r2.y); v[11] = bf_hi(r2.y); v[12] = bf_lo(r2.z); v[13] = bf_hi(r2.z); v[14] = bf_lo(r2.w); v[15] = bf_hi(r2.w);
        float s = 0.f;
#pragma unroll
        for (int j = 0; j < 16; ++j) s += v[j] * v[j];
        float rs = rsqrtf(wave_sum(s) * (1.f / 1024.f) + RMS_EPS);
        if (DBG_NO_ATT) rs = 0.f;
        v4u o, o2; o.x = cvt_pk_bf16(v[0] * rs, v[1] * rs); o.y = cvt_pk_bf16(v[2] * rs, v[3] * rs); o.z = cvt_pk_bf16(v[4] * rs, v[5] * rs); o.w = cvt_pk_bf16(v[6] * rs, v[7] * rs);
        o2.x = cvt_pk_bf16(v[8] * rs, v[9] * rs); o2.y = cvt_pk_bf16(v[10] * rs, v[11] * rs); o2.z = cvt_pk_bf16(v[12] * rs, v[13] * rs); o2.w = cvt_pk_bf16(v[14] * rs, v[15] * rs);
        *((v4u*)(YC + (size_t)m * DM + D_SSM) + lane) = o; *((v4u*)(YC + (size_t)m * DM + D_SSM) + lane + 64) = o2; }
}

namespace att {
constexpr int NW = 8, QBLK = 32, KVBLK = 64;
constexpr float SCALE = 0.07216878364870322f;
constexpr float THR = 8.f;
constexpr int SHM_V = KVBLK * 128 * 2, SHM_K = KVBLK * QKD * 2;
constexpr int SHM_ATTN = 3 * SHM_V + 3 * SHM_K + NW * 64 * 4;
#define KSW(row, ch) ((row) * 384 + ((((ch)) ^ (((row) >> 1) & 7)) << 4))
#define SBAR() __builtin_amdgcn_sched_barrier(0)
__device__ __forceinline__ int crow(int r, int hi) { return (r & 3) + 8 * (r >> 2) + 4 * hi; }
__device__ __forceinline__ void partialSM(f32x16& p0, f32x16& p1, float& m_reg, float& mn, float& alpha) {
    constexpr float C = SCALE * 1.4426950408889634f;
    float pmax = p0[0];
#pragma unroll
    for (int r = 1; r < 16; ++r) pmax = fmaxf(pmax, p0[r]);
#pragma unroll
    for (int r = 0; r < 16; ++r) pmax = fmaxf(pmax, p1[r]);
    { auto rr = __builtin_amdgcn_permlane32_swap(__float_as_uint(pmax), __float_as_uint(pmax), false, false);
      pmax = fmaxf(__uint_as_float(rr[0]), __uint_as_float(rr[1])); }
    if (__builtin_expect(__all(pmax - m_reg <= THR / SCALE), 1)) { mn = m_reg; alpha = 1.f; }
    else { mn = fmaxf(m_reg, pmax); alpha = __builtin_amdgcn_exp2f((m_reg - mn) * C); m_reg = mn; }
    const float mnC = -mn * C;
#pragma unroll
    for (int r = 0; r < 16; ++r) p0[r] = fmaf(p0[r], C, mnC);
#pragma unroll
    for (int r = 0; r < 16; ++r) p1[r] = fmaf(p1[r], C, mnC);
#pragma unroll
    for (int r = 0; r < 16; ++r) p0[r] = __builtin_amdgcn_exp2f(p0[r]);
}
__device__ __forceinline__ void finishSM(f32x16& p0, f32x16& p1, float alpha, float& l_reg, bf16x8& pa0, bf16x8& pa1, bf16x8& pa2, bf16x8& pa3) {
#pragma unroll
    for (int r = 0; r < 16; ++r) p1[r] = __builtin_amdgcn_exp2f(p1[r]);
    float ps = 0;
#pragma unroll
    for (int r = 0; r < 16; ++r) ps += p0[r];
#pragma unroll
    for (int r = 0; r < 16; ++r) ps += p1[r];
    { auto rr = __builtin_amdgcn_permlane32_swap(__float_as_uint(ps), __float_as_uint(ps), false, false);
      ps = __uint_as_float(rr[0]) + __uint_as_float(rr[1]); }
    l_reg = l_reg * alpha + ps;
#define PK4(P, BASE, OUT) do { unsigned a0 = cvt_pk_bf16(P[BASE + 0], P[BASE + 1]), a1 = cvt_pk_bf16(P[BASE + 2], P[BASE + 3]);   \
    unsigned b0 = cvt_pk_bf16(P[BASE + 4], P[BASE + 5]), b1 = cvt_pk_bf16(P[BASE + 6], P[BASE + 7]);                              \
    auto r0 = __builtin_amdgcn_permlane32_swap(a0, b0, false, false); auto r1 = __builtin_amdgcn_permlane32_swap(a1, b1, false, false); \
    v4u w_ = {r0[0], r1[0], r0[1], r1[1]}; OUT = __builtin_bit_cast(bf16x8, w_); } while (0)
    PK4(p0, 0, pa0); PK4(p0, 8, pa1); PK4(p1, 0, pa2); PK4(p1, 8, pa3);
#undef PK4
}
__device__ __forceinline__ void qkt(f32x16& p0, f32x16& p1, const LAS unsigned char* Ks, const bf16x8 (&qr)[12], int r32, int hi) {
    p0 = f32x16{}; p1 = f32x16{};
#pragma unroll
    for (int d0 = 0; d0 < 12; ++d0) { const int ch = d0 * 2 + hi;
        const bf16x8 b0 = *(const LAS bf16x8*)(Ks + KSW(r32, ch));
        const bf16x8 b1 = *(const LAS bf16x8*)(Ks + 32 * 384 + KSW(r32, ch));
        p0 = __builtin_amdgcn_mfma_f32_32x32x16_bf16(b0, qr[d0], p0, 0, 0, 0);
        p1 = __builtin_amdgcn_mfma_f32_32x32x16_bf16(b1, qr[d0], p1, 0, 0, 0); }
}
__device__ __forceinline__ int v_st(int k, int c) { const int kk = (k & ~0xC) | ((k & 4) << 1) | ((k & 8) >> 1); return ((kk >> 3) * 4 + (c >> 5)) * 512 + ((kk & 7) * 32 + (c & 31)) * 2; }
__device__ __forceinline__ int v_rd_base(int lane) { return ((lane & 3) << 3) | (((lane >> 2) & 3) << 6) | (((lane >> 4) & 1) << 5) | (((lane >> 5) & 1) << 8); }
constexpr int v_rd_off(int d0, int ks, int half) { return d0 * 512 + ks * 4096 + half * 2048; }
template <int OFF> __device__ __forceinline__ s16x4 tr_read(int vb) {
    s16x4 r; asm volatile("ds_read_b64_tr_b16 %0, %1 offset:%2" : "=&v"(r) : "v"(vb), "i"(OFF) : "memory"); return r;
}
template <int D0> __device__ __forceinline__ void pv_one(f32x16& od, int vb, bf16x8 pa0, bf16x8 pa1, bf16x8 pa2, bf16x8 pa3) {
    const s16x4 l0 = tr_read<v_rd_off(D0, 0, 0)>(vb), h0 = tr_read<v_rd_off(D0, 0, 1)>(vb), l1 = tr_read<v_rd_off(D0, 1, 0)>(vb), h1 = tr_read<v_rd_off(D0, 1, 1)>(vb);
    const s16x4 l2 = tr_read<v_rd_off(D0, 2, 0)>(vb), h2 = tr_read<v_rd_off(D0, 2, 1)>(vb), l3 = tr_read<v_rd_off(D0, 3, 0)>(vb), h3 = tr_read<v_rd_off(D0, 3, 1)>(vb);
    asm volatile("s_waitcnt lgkmcnt(0)" ::: "memory"); SBAR();
#define PK(L, H) (bf16x8){L[0], L[1], L[2], L[3], H[0], H[1], H[2], H[3]}
    od = __builtin_amdgcn_mfma_f32_32x32x16_bf16(pa0, PK(l0, h0), od, 0, 0, 0);
    od = __builtin_amdgcn_mfma_f32_32x32x16_bf16(pa1, PK(l1, h1), od, 0, 0, 0);
    od = __builtin_amdgcn_mfma_f32_32x32x16_bf16(pa2, PK(l2, h2), od, 0, 0, 0);
    od = __builtin_amdgcn_mfma_f32_32x32x16_bf16(pa3, PK(l3, h3), od, 0, 0, 0);
#undef PK
}
__device__ __forceinline__ void pv_d0(f32x16* o, int vb, bf16x8 pa0, bf16x8 pa1, bf16x8 pa2, bf16x8 pa3) {
    pv_one<0>(o[0], vb, pa0, pa1, pa2, pa3); pv_one<1>(o[1], vb, pa0, pa1, pa2, pa3); pv_one<2>(o[2], vb, pa0, pa1, pa2, pa3); pv_one<3>(o[3], vb, pa0, pa1, pa2, pa3);
}
__device__ __forceinline__ void attn_unit(const bf16* __restrict__ Qb, const bf16* __restrict__ KNh, const bf16* __restrict__ KPb, const bf16* __restrict__ Vh, bf16* __restrict__ Ob, LAS unsigned char* lds) {
    int tid = threadIdx.x; asm volatile("" : "+v"(tid));
    const int wid = __builtin_amdgcn_readfirstlane(tid >> 6), lane = tid & 63, r32 = lane & 31, hi = lane >> 5;
    constexpr int NSLOT = 3;
    LAS unsigned char* V_lds = lds; LAS unsigned char* K_lds = lds + NSLOT * SHM_V;
    LAS float* wsf = (LAS float*)(lds + NSLOT * (SHM_V + SHM_K)) + wid * 64; LAS float* li_l = wsf; LAS float* al_l = wsf + 32;
    float m_reg = -1e30f, l_reg = 0; f32x16 o[4] = {}; bf16x8 qr[12];
    const bf16* Qw = Qb + (size_t)(wid * QBLK + r32) * QKD + hi * 8;
#pragma unroll
    for (int d0 = 0; d0 < 12; ++d0) qr[d0] = *(const bf16x8*)(Qw + d0 * 16);
    const char* kp[3]; unsigned kst[3]; const char* vp[2];
#pragma unroll
    for (int i = 0; i < 3; ++i) { const int P = (8 * i + wid) * 64 + lane, row = P / 24, chp = P - row * 24, ch = chp ^ ((row >> 1) & 7);
        if (ch < 16) { kp[i] = (const char*)(KNh + (size_t)row * 128 + ch * 8); kst[i] = KVBLK * 128 * 2; } else { kp[i] = (const char*)(KPb + (size_t)row * 64 + (ch - 16) * 8); kst[i] = KVBLK * 64 * 2; } }
#pragma unroll
    for (int i = 0; i < 2; ++i) { const int P = (8 * i + wid) * 64 + lane, s = P >> 5, within = P & 31, kk = (s >> 2) * 8 + (within >> 2), c = (s & 3) * 32 + (within & 3) * 8;
        const int k = (kk & ~0xC) | ((kk & 4) << 1) | ((kk & 8) >> 1);
        vp[i] = (const char*)(Vh + (size_t)k * 128 + c); }
    const int vb0 = (int)(uintptr_t)V_lds + v_rd_base(lane);
#define DMA_TILE(slot) do { _Pragma("unroll") for (int i_ = 0; i_ < 3; ++i_) { __builtin_amdgcn_global_load_lds((const unsigned*)kp[i_], (LAS unsigned*)(K_lds + (slot) * SHM_K + (8 * i_ + wid) * 1024), 16, 0, 0); kp[i_] += kst[i_]; } \
    _Pragma("unroll") for (int i_ = 0; i_ < 2; ++i_) { __builtin_amdgcn_global_load_lds((const unsigned*)vp[i_], (LAS unsigned*)(V_lds + (slot) * SHM_V + (8 * i_ + wid) * 1024), 16, 0, 0); vp[i_] += KVBLK * 128 * 2; } } while (0)
#define SWAIT() asm volatile("s_waitcnt vmcnt(0)" ::: "memory")
#define RESC(a) do { if (__any((a) < 1.f)) { if (hi == 0) al_l[r32] = (a); asm volatile("s_waitcnt lgkmcnt(0)" ::: "memory"); \
    _Pragma("unroll") for (int d = 0; d < 4; ++d) _Pragma("unroll") for (int r = 0; r < 16; ++r) o[d][r] *= al_l[crow(r, hi)]; } } while (0)
    f32x16 p0, p1; float mn, al; bf16x8 pa0, pa1, pa2, pa3; constexpr int NTL = SEQ / KVBLK;
    const int grp = wid >> 2;
    __syncthreads();
    DMA_TILE(0); DMA_TILE(1); SWAIT();
    __syncthreads();
#define STAGE_NEXT(j, s2) do { SWAIT(); if ((j) + 2 < NTL) DMA_TILE(s2); } while (0)
#define SM_PV(s0) do { partialSM(p0, p1, m_reg, mn, al); RESC(al); finishSM(p0, p1, al, l_reg, pa0, pa1, pa2, pa3); SBAR(); pv_d0(o, vb0 + (s0) * SHM_V, pa0, pa1, pa2, pa3); } while (0)
    if (grp == 0) {
        int s0 = 0, s2 = 2;
#pragma unroll 1
        for (int j = 0; j < NTL; ++j) {
            SBAR(); qkt(p0, p1, K_lds + s0 * SHM_K, qr, r32, hi);
            __syncthreads();
            STAGE_NEXT(j, s2);
            SM_PV(s0);
            __syncthreads();
            s0 = (s0 == 2) ? 0 : s0 + 1; s2 = (s2 == 2) ? 0 : s2 + 1;
        }
        __syncthreads();
    } else {
        int s0 = 0, s2 = 2;
        __syncthreads();
#pragma unroll 1
        for (int j = 0; j < NTL; ++j) {
            STAGE_NEXT(j, s2);
            SBAR(); qkt(p0, p1, K_lds + s0 * SHM_K, qr, r32, hi);
            __syncthreads();
            SM_PV(s0);
            __syncthreads();
            s0 = (s0 == 2) ? 0 : s0 + 1; s2 = (s2 == 2) ? 0 : s2 + 1;
        }
    }
#undef STAGE_NEXT
#undef SM_PV
    if (hi == 0) li_l[r32] = l_reg; asm volatile("s_waitcnt lgkmcnt(0)" ::: "memory");
    float rli[16];
#pragma unroll
    for (int r = 0; r < 16; ++r) rli[r] = __builtin_amdgcn_rcpf(li_l[crow(r, hi)]);
    bf16* Ow = Ob + (size_t)(wid * QBLK) * 1024;
#pragma unroll
    for (int r = 0; r < 16; ++r) { const int orow = crow(r, hi);
#pragma unroll
        for (int d0 = 0; d0 < 4; ++d0) Ow[(size_t)orow * 1024 + d0 * 32 + r32] = (bf16)(cvt_pk_bf16(o[d0][r] * rli[r], 0.f) & 0xffffu); }
#undef DMA_TILE
#undef SWAIT
#undef RESC
}
}

typedef int i32x4 __attribute__((ext_vector_type(4)));
__device__ __forceinline__ void moe_tables(Frame& F, bool need_bases) {
    volatile LAS int* M = (volatile LAS int*)F.MISC;
    const int* UC = (const int*)(F.ws + WS_RTS);
    LAS int* SC = (LAS int*)F.lds;
    __syncthreads();
    { const int e4 = F.tid & 7, ul = F.tid >> 3; const int c = F.c, G = F.G;
      i32x4 acc[5];
#pragma unroll
      for (int j = 0; j < 5; ++j) acc[j] = (i32x4){0, 0, 0, 0};
#pragma unroll 4
      for (int i = 0; i < 16; ++i) { const int u = ul + 64 * i; const i32x4 v = *(const i32x4*)(UC + u * 32 + 4 * e4);
          acc[0] += v;
          if (need_bases) {
#pragma unroll
              for (int j = 0; j < 4; ++j) acc[1 + j] += (u < c + j * G) ? v : (i32x4){0, 0, 0, 0}; } }
#pragma unroll
      for (int j = 0; j < 5; ++j)
#pragma unroll
          for (int r = 0; r < 4; ++r) { int x = acc[j][r]; x += __shfl_xor(x, 8); x += __shfl_xor(x, 16); x += __shfl_xor(x, 32); acc[j][r] = x; }
      if (F.lane < 8) {
#pragma unroll
          for (int j = 0; j < 5; ++j) *(LAS i32x4*)(SC + (F.wave * 5 + j) * 32 + 4 * e4) = acc[j]; } }
    __syncthreads();
    if (F.tid < 160) { const int j = F.tid >> 5, e = F.tid & 31; int s = 0;
#pragma unroll
        for (int w = 0; w < 8; ++w) s += SC[(w * 5 + j) * 32 + e];
        if (j == 0) M[16 + e] = s; else M[960 + 32 * (j - 1) + e] = s; }
    __syncthreads();
    if (F.tid == 0) { int off = 0; for (int e = 0; e < NEXP; ++e) { M[64 + e] = off; off += (M[16 + e] + 255) & ~255; } M[48] = off >> 8; }
    __syncthreads();
    const int T = M[48];
    for (int t = F.tid; t < T; t += NWAVES * 64) { int e = 0;
        for (int k = 0; k < NEXP; ++k) { const int st = M[64 + k], pd = (M[16 + k] + 255) & ~255; if (st <= t * 256 && t * 256 < st + pd) e = k; }
        M[128 + t] = e; }
    __syncthreads();
}

struct RStep { v4u h[4]; f32x4 g[2]; bf16x8 w[4]; };
template <int MODE = 0>
__device__ __forceinline__ void router_phase(Frame& F) {
    const int lane = F.lane, fr = lane & 15, fq = lane >> 4, w = F.wave;
    unsigned char* ws = F.ws;
    const bf16* H = (const bf16*)(ws + WS_H); const float* n2 = F.in[I_NORM2];
    const float* ss2p = (const float*)(ws + WS_SS2P);
    unsigned char* XN8 = ws + WS_XN;
    LAS unsigned char* stg = F.lds + w * 16384;
    LAS float* LG = (LAS float*)(F.lds + w * 16384 + 8192);
    int* tok_e = (int*)(ws + WS_TOKE); int* tok_p = (int*)(ws + WS_TOKP); float* tok_g = (float*)(ws + WS_TOKG); int* uc = (int*)(ws + WS_RTS);
    const int iters = (NT / 64 + F.G - 1) / F.G;
    for (int it = 0; it < iters; ++it) {
        const int blk = it * F.G + F.c; const bool valid = blk < NT / 64;
        const int tok0 = 64 * (valid ? blk : 0);
        float rs[4];
#pragma unroll
        for (int tf = 0; tf < 4; ++tf) { const float* pz = ss2p + (size_t)(tok0 + 16 * tf + fr) * 32 + 8 * fq; const f32x4 a = *(const f32x4*)pz, b = *(const f32x4*)(pz + 4);
            float ssum = ((a[0] + a[1]) + (a[2] + a[3])) + ((b[0] + b[1]) + (b[2] + b[3])); ssum += __shfl_xor(ssum, 16); ssum += __shfl_xor(ssum, 32);
            rs[tf] = rsqrtf(ssum * (1.f / DM) + RMS_EPS); }
        int kofs = w * 256 + 8 * fq;
        asm volatile("" : "+v"(kofs));
        const bf16* hrow = H + (size_t)(tok0 + fr) * DM + kofs;
        const bf16* wh0 = (const bf16*)(ws + WS_WRT) + (size_t)fr * DM + kofs;
        f32x4 acc[4][2];
#pragma unroll
        for (int tf = 0; tf < 4; ++tf) { acc[tf][0] = (f32x4){0.f, 0.f, 0.f, 0.f}; acc[tf][1] = (f32x4){0.f, 0.f, 0.f, 0.f}; }
        auto load = [&](RStep& b, int s) {
#pragma unroll
            for (int tf = 0; tf < 4; ++tf) b.h[tf] = *(const v4u*)(hrow + (size_t)(16 * tf) * DM + 32 * s);
            b.g[0] = *(const f32x4*)(n2 + kofs + 32 * s); b.g[1] = *(const f32x4*)(n2 + kofs + 32 * s + 4);
            b.w[0] = *(const bf16x8*)(wh0 + 32 * s); b.w[1] = *(const bf16x8*)(wh0 + 16 * DM + 32 * s); b.w[2] = *(const bf16x8*)(wh0 + NEXP * DM + 32 * s); b.w[3] = *(const bf16x8*)(wh0 + (NEXP + 16) * DM + 32 * s); };
        auto compute = [&](const RStep& b, int s) {
            const f32x4 g0 = b.g[0] * X8_SCALE, g1 = b.g[1] * X8_SCALE;
#pragma unroll
            for (int tf = 0; tf < 4; ++tf) { const v4u hx = b.h[tf]; const float r = rs[tf];
                const f32x4 ha = (f32x4){bf_lo(hx.x), bf_hi(hx.x), bf_lo(hx.y), bf_hi(hx.y)}, hb = (f32x4){bf_lo(hx.z), bf_hi(hx.z), bf_lo(hx.w), bf_hi(hx.w)};
                { v2u o; o.x = pk4_fp8(ha[0] * r * g0[0], ha[1] * r * g0[1], ha[2] * r * g0[2], ha[3] * r * g0[3]); o.y = pk4_fp8(hb[0] * r * g1[0], hb[1] * r * g1[1], hb[2] * r * g1[2], hb[3] * r * g1[3]);
                  *(LAS v2u*)(stg + (16 * tf + fr) * 256 + ((s ^ (fr & 7)) << 5) + 8 * fq) = o; }
                const bf16x8 bh = __builtin_bit_cast(bf16x8, hx);
                acc[tf][0] = __builtin_amdgcn_mfma_f32_16x16x32_bf16(b.w[0], bh, acc[tf][0], 0, 0, 0); acc[tf][1] = __builtin_amdgcn_mfma_f32_16x16x32_bf16(b.w[1], bh, acc[tf][1], 0, 0, 0);
                acc[tf][0] = __builtin_amdgcn_mfma_f32_16x16x32_bf16(b.w[2], bh, acc[tf][0], 0, 0, 0); acc[tf][1] = __builtin_amdgcn_mfma_f32_16x16x32_bf16(b.w[3], bh, acc[tf][1], 0, 0, 0); } };
        if (valid) {
            RStep A, B; load(A, 0);
#pragma unroll
            for (int s = 0; s < 8; s += 2) { load(B, s + 1); SBAR(); compute(A, s); SBAR(); if (s + 2 < 8) load(A, s + 2); SBAR(); compute(B, s + 1); SBAR(); }
            LDS_WAIT(); asm volatile("" ::: "memory");
#pragma unroll
            for (int i = 0; i < 16; ++i) { const int t = 4 * i + fq, j = fr;
                *(v4u*)(XN8 + (size_t)(tok0 + t) * DM + w * 256 + j * 16) = *(const LAS v4u*)(stg + t * 256 + (((j >> 1) ^ (t & 7)) << 5) + (j & 1) * 16); }
            LDS_WAIT(); asm volatile("" ::: "memory");
#pragma unroll
            for (int tf = 0; tf < 4; ++tf) { *(LAS f32x4*)(stg + ((16 * tf + fr) * 32 + 4 * fq) * 4) = acc[tf][0]; *(LAS f32x4*)(stg + ((16 * tf + fr) * 32 + 16 + 4 * fq) * 4) = acc[tf][1]; }
        }
        __syncthreads();
        if (valid && w < 4) {
        const int u = blk * 4 + w;
        f32x4 acc0 = (f32x4){0.f, 0.f, 0.f, 0.f}, acc1 = (f32x4){0.f, 0.f, 0.f, 0.f};
#pragma unroll
        for (int ww = 0; ww < 8; ++ww) { const LAS unsigned char* pp = F.lds + ww * 16384 + ((16 * w + fr) * 32 + 4 * fq) * 4; acc0 += *(const LAS f32x4*)pp; acc1 += *(const LAS f32x4*)(pp + 64); }
        const float rsu = (w == 0) ? rs[0] : (w == 1) ? rs[1] : (w == 2) ? rs[2] : rs[3];
        *(LAS f32x4*)(LG + fr * 32 + 4 * fq) = acc0 * rsu; *(LAS f32x4*)(LG + fr * 32 + 16 + 4 * fq) = acc1 * rsu;
        LDS_WAIT(); asm volatile("" ::: "memory");
        {
            const float* br = F.in[I_BR]; float v[32];
#pragma unroll
            for (int e = 0; e < 32; ++e) v[e] = LG[(lane & 15) * 32 + e] + br[e];
            unsigned taken = 0u; float tv[4]; int te[4];
#pragma unroll
            for (int k = 0; k < 4; ++k) { float best = -3.0e38f; int bi = 0;
#pragma unroll
                for (int e = 0; e < 32; ++e) { const bool ok = !((taken >> e) & 1u) && v[e] > best; best = ok ? v[e] : best; bi = ok ? e : bi; }
                taken |= 1u << bi; tv[k] = best; te[k] = (lane < 16) ? bi : -1; }
            int rk[4] = {0, 0, 0, 0}, myc = 0; const unsigned long long low = (1ull << lane) - 1ull;
#pragma unroll 2
            for (int e = 0; e < 32; ++e) {
                const unsigned long long b0 = __ballot(te[0] == e), b1 = __ballot(te[1] == e), b2 = __ballot(te[2] == e), b3 = __ballot(te[3] == e);
                const int lower = __popcll(b0 & low) + __popcll(b1 & low) + __popcll(b2 & low) + __popcll(b3 & low);
                const int cnt = __popcll(b0) + __popcll(b1) + __popcll(b2) + __popcll(b3);
#pragma unroll
                for (int k = 0; k < 4; ++k) rk[k] = (te[k] == e) ? lower : rk[k];
                myc = (lane == e) ? cnt : myc; }
            if (lane < 32) uc[u * 32 + lane] = myc;
            if (lane < 16) {
                const float e1 = __expf(tv[1] - tv[0]), e2 = __expf(tv[2] - tv[0]), e3 = __expf(tv[3] - tv[0]); const float inv = 1.f / (1.f + e1 + e2 + e3);
                const float gk[4] = {inv, e1 * inv, e2 * inv, e3 * inv};
                const int tk = 16 * u + lane;
#pragma unroll
                for (int k = 0; k < 4; ++k) { tok_e[tk * 4 + k] = te[k]; tok_p[tk * 4 + k] = rk[k]; tok_g[tk * 4 + k] = gk[k]; }
            }
        }
        LDS_WAIT(); asm volatile("" ::: "memory");
        }
        __syncthreads();
    }
}

__device__ __forceinline__ void gather_phase(Frame& F) {
    volatile LAS int* M = (volatile LAS int*)F.MISC;
    unsigned char* ws = F.ws; const int* tok_e = (const int*)(ws + WS_TOKE); const int* tok_p = (const int*)(ws + WS_TOKP); int* tok_r = (int*)(ws + WS_TOKR); int* rtok = (int*)(ws + WS_XG);
    if (F.c < NEXP) { const int cnt = M[16 + F.c], st = M[64 + F.c], pd = (cnt + 255) & ~255; for (int r = cnt + F.tid; r < pd; r += NWAVES * 64) rtok[st + r] = 0; }
    for (int ju = 0; ju < 4; ++ju) { const int u = F.c + ju * F.G; if (u >= NT / 16) break;
        if (F.tid < 64) { const int i = 64 * u + F.tid, e = tok_e[i], row = M[64 + e] + M[960 + 32 * ju + e] + tok_p[i];
            tok_r[i] = row; rtok[row] = i >> 2; }
    }
}

__device__ __forceinline__ void final_phase(Frame& F) {
    const int gw = F.c * NWAVES + F.wave, NGW = F.G * NWAVES, lane = F.lane;
    unsigned char* ws = F.ws; const bf16* H = (const bf16*)(ws + WS_H); const unsigned char* Y = ws + WS_Y;
    const int* tok_p = (const int*)(ws + WS_TOKR); const float* tok_g = (const float*)(ws + WS_TOKG); const float* fw = F.in[I_FNW];
    for (int t = gw; t < NT; t += NGW) {
        f32x4 v[8]; const v2u* hr = (const v2u*)(H + (size_t)t * DM) + lane;
#pragma unroll
        for (int j = 0; j < 8; ++j) { const v2u hx = hr[64 * j]; v[j] = (f32x4){bf_lo(hx.x), bf_hi(hx.x), bf_lo(hx.y), bf_hi(hx.y)}; }
#if DBG_PROBE
        { f32x4* orow_ = (f32x4*)(F.out + (size_t)t * DM) + lane;
#pragma unroll
          for (int j = 0; j < 8; ++j) { f32x4 q_;
#if DBG_PROBE_F32
              q_ = *((const f32x4*)((const float*)(ws + DBG_PROBE_OFF) + (size_t)t * DBG_PROBE_LD) + ((lane + 64 * j) % (DBG_PROBE_LD / 4)));
#else
              { const v2u r_ = *((const v2u*)((const bf16*)(ws + DBG_PROBE_OFF) + (size_t)t * DBG_PROBE_LD) + ((lane + 64 * j) % (DBG_PROBE_LD / 4))); q_[0] = bf_lo(r_.x); q_[1] = bf_hi(r_.x); q_[2] = bf_lo(r_.y); q_[3] = bf_hi(r_.y); }
#endif
              q_ = q_ * 64.f; q_[0] -= floorf(q_[0]); q_[1] -= floorf(q_[1]); q_[2] -= floorf(q_[2]); q_[3] -= floorf(q_[3]); orow_[64 * j] = q_; }
          continue; }
#endif
        if (!DBG_NO_MOE) {
#pragma unroll
            for (int k = 0; k < 4; ++k) { const int row = tok_p[t * 4 + k]; const float g = tok_g[t * 4 + k] * (1.f / Y8_SCALE); const unsigned* yr = (const unsigned*)(Y + (size_t)row * DM) + lane;
#pragma unroll
                for (int j = 0; j < 8; ++j) { const unsigned y = __builtin_nontemporal_load(yr + 64 * j);
                    const f32x2 lo = __builtin_amdgcn_cvt_pk_f32_fp8((int)y, false), hi = __builtin_amdgcn_cvt_pk_f32_fp8((int)y, true);
                    v[j][0] += g * lo[0]; v[j][1] += g * lo[1]; v[j][2] += g * hi[0]; v[j][3] += g * hi[1]; } }
        }
        float s = 0.f;
#pragma unroll
        for (int j = 0; j < 8; ++j) s += v[j][0] * v[j][0] + v[j][1] * v[j][1] + v[j][2] * v[j][2] + v[j][3] * v[j][3];
        const float rs = rsqrtf(wave_sum(s) * (1.f / DM) + RMS_EPS);
        f32x4* orow = (f32x4*)(F.out + (size_t)t * DM) + lane;
#pragma unroll
        for (int j = 0; j < 8; ++j) { const f32x4 g = *((const f32x4*)fw + lane + 64 * j); __builtin_nontemporal_store(v[j] * rs * g, orow + 64 * j); }
    }
}

struct Args { const float* in[26]; float* out; unsigned char* ws; int ph_lo, ph_hi; };
__global__ void __launch_bounds__(NWAVES * 64, 2) hymba_fwd(Args args) {
    extern __shared__ __attribute__((aligned(16))) unsigned char lds_raw[];
    Frame F;
    F.lds = (LAS unsigned char*)lds_raw;
    F.MISC = (volatile LAS unsigned*)(F.lds + MISC_OFF);
    F.tid = threadIdx.x; F.lane = F.tid & 63; F.wave = __builtin_amdgcn_readfirstlane(F.tid >> 6);
    F.G = gridDim.x; F.c = blockIdx.x;
    F.ws = args.ws; F.ctl = (gu32*)(args.ws + WS_CTL); F.out = args.out;
#pragma unroll
    for (int i = 0; i < 26; ++i) F.in[i] = args.in[i];
    for (int u = F.tid; u < (LDS_BYTES - MISC_OFF) / 4; u += NWAVES * 64) F.MISC[u] = 0u;
    __syncthreads();
    const int lo = args.ph_lo, hi = args.ph_hi;
    XcdBarrier bar; bar.bar = (unsigned*)(F.ctl + CW_BAR); bar.x = 0; bar.st = nullptr;
    if (hi - lo > 1) bar = xcd_barrier_post((unsigned*)(F.ctl + CW_BAR), F.MISC);
#ifdef ONLY_PHASE
#define IN(k) ((k) == ONLY_PHASE && lo <= (k) && (k) < hi)
#else
#define IN(k) (lo <= (k) && (k) < hi)
#endif
#define SEAM(k) do { if (IN(k) && IN((k) + 1)) xcd_barrier(bar); } while (0)
    unsigned char* ws = args.ws;
    const int G = F.G, c = F.c;

    if (IN(0)) { p0_prologue(F);
#if DBG_REP == 7
        xcd_barrier(bar); p0_prologue(F);
#endif
    }
    SEAM(0);
    if (IN(1)) {
        pg8::DenseOrder S; S.init(ws + WS_XN, DM, ws + WS_WIN, DM, NT, NIN_PAD, G, c);
        EpiInProj E{(bf16*)(ws + WS_PROJ), (bf16*)(ws + WS_KPE), (float*)(ws + WS_DT), (float*)(ws + WS_SSP), (const float*)(ws + WS_ROPE)};
        pg8::gemm_phase<false>(F.lds, pg8::Geo{DM, DM, DM}, S, E);
#if DBG_REP == 1
        xcd_barrier(bar); pg8::gemm_phase<false>(F.lds, pg8::Geo{DM, DM, DM}, S, E);
#endif
        {
          const int rem = ((NT / 256) * (NIN_PAD / 256)) % G, t0 = rem ? rem : 0;
          if (c >= t0) { const int st = (c - t0) * NWAVES + F.wave, sd = (G - t0) * NWAVES; dense_weights_tail(F, st, sd); moe_convert_range(F, 0, MOE_PRE1, st, sd); } }
#if DBG_REP == 22
        { xcd_barrier(bar); pg8::DenseOrder S2 = S; S2.tstepA = 0; S2.tstepB = 0; EpiNull E2{ws + WS_Y}; pg8::gemm_phase<false>(F.lds, pg8::Geo{DM, DM, DM}, S2, E2); }
#endif
#if DBG_REP == 21
        { xcd_barrier(bar); EpiNull E2{ws + WS_Y}; pg8::gemm_phase<false>(F.lds, pg8::Geo{DM, DM, DM}, S, E2); }
#endif
    }
    SEAM(1);
    if (IN(2)) {
#if DBG_REP == 2
        for (int u = c; u < BATCH * NCHUNK * NGRP * 2; u += G) ssd_local_unit(F, u);
        xcd_barrier(bar);
#endif
        for (int u = c; u < BATCH * NCHUNK * NGRP * 2; u += G) ssd_local_unit(F, u);
        __syncthreads();
        { pg8::DenseOrder S; S.init(ws + WS_PROJ + (size_t)PC_QA * 2, NPROJ, ws + WS_WQB, Q_LORA, NT, MLA_H * QKD, G, c);
          EpiQB E{(bf16*)(ws + WS_Q), (const float*)(ws + WS_SSP), (const float*)(ws + WS_ROPE)};
          pg8::gemm_phase<false>(F.lds, pg8::Geo{NPROJ, Q_LORA, Q_LORA}, S, E); }
        { pg8::DenseOrder S; S.init(ws + WS_PROJ + (size_t)PC_KVA * 2, NPROJ, ws + WS_WKVB, KV_LORA, NT, MLA_H * 256, G, c); S.skew = 0;
          EpiKVB E{(bf16*)(ws + WS_KN), (bf16*)(ws + WS_V), (const float*)(ws + WS_SSP)};
          pg8::gemm_phase<false>(F.lds, pg8::Geo{NPROJ, KV_LORA, KV_LORA}, S, E); }
        {
          const int rem = ((NT / 256) * (MLA_H * QKD / 256)) % G, t0 = rem ? rem : 0;
          if (c >= t0) moe_convert_range(F, MOE_PRE1, MOE_PRE1 + MOE_PRE2, (c - t0) * NWAVES + F.wave, (G - t0) * NWAVES); }
    }
    SEAM(2);
    if (IN(3)) {
        const int x = c & 7, q = c >> 3, G8 = G >> 3;
        const int team = x * 2 + ((q >> 4) & 1), grp = team % 3;
        const int nteam = 2 * 8, gteams = (nteam - grp + 2) / 3, grank = (team / 3) * 16 + (q & 15), gsize = gteams * 16;
        constexpr int NREM = MOE_NIT - MOE_PRE1 - MOE_PRE2;
        const int tb0 = (grp == 0) ? 0 : (grp == 1) ? (nteam + 2) / 3 : (nteam + 2) / 3 + (nteam + 1) / 3, tb1 = tb0 + gteams;
        const int cv_lo = MOE_PRE1 + MOE_PRE2 + (int)((long)tb0 * NREM / nteam), cv_hi = MOE_PRE1 + MOE_PRE2 + (int)((long)tb1 * NREM / nteam);
#if DBG_REP == 3
#pragma unroll 1
        for (int rep_ = 0; rep_ < 2; ++rep_) { if (rep_) xcd_barrier(bar);
#else
        { constexpr int rep_ = 0;
#endif
#pragma unroll 1
        for (int s = 0; ; ++s) {
            if (s == grp && rep_ == 0) { for (int it = c; it < BATCH * SSM_HEADS * 2 * 2; it += G) ssd_scan_item(F, it); moe_convert_range(F, cv_lo, cv_hi, grank * NWAVES + F.wave, gsize * NWAVES); }
            const int v = s * G8 + q; const int pr = v >> 4, qb = v & 15;
            if (pr >= 4) { if (s >= grp) break; else continue; }
            const int pair = pr * 8 + x, b = pair >> 3, h = pair & 7;
            const size_t bh = (size_t)(b * MLA_H + h);
            att::attn_unit((const bf16*)(ws + WS_Q) + (bh * SEQ + qb * 256) * QKD, (const bf16*)(ws + WS_KN) + bh * SEQ * 128, (const bf16*)(ws + WS_KPE) + (size_t)b * SEQ * 64,
                           (const bf16*)(ws + WS_V) + bh * SEQ * 128, (bf16*)(ws + WS_O) + ((size_t)(b * SEQ + qb * 256)) * 1024 + h * 128, F.lds);
        }
        }
    }
    SEAM(3);
    if (IN(4)) {
#if DBG_REP == 4
        for (int u = c; u < BATCH * NCHUNK * NGRP; u += G) ssd_out_unit(F, u);
        xcd_barrier(bar);
#endif
        for (int u = c; u < BATCH * NCHUNK * NGRP; u += G) ssd_out_unit(F, u);
        att_norm_rows(F);
    }
    SEAM(4);
    if (IN(5)) {
        pg8::DenseOrder S; S.init(ws + WS_YCAT, DM, ws + WS_WOUT, DM, NT, DM, G, c);
        EpiOut E{F.in[I_X], (bf16*)(ws + WS_H), (float*)(ws + WS_SS2P)};
        pg8::gemm_phase<false>(F.lds, pg8::Geo{DM, DM, DM}, S, E);
#if DBG_REP == 9 + 1
        xcd_barrier(bar); pg8::gemm_phase<false>(F.lds, pg8::Geo{DM, DM, DM}, S, E);
#endif
    }
    SEAM(5);
    if (IN(6)) { router_phase(F);
#if DBG_REP == 6
        xcd_barrier(bar); router_phase(F);
#endif
#if DBG_REP == 16
        xcd_barrier(bar); router_phase<1>(F);
#endif
#if DBG_REP == 17
        xcd_barrier(bar); router_phase<2>(F);
#endif
    }
    SEAM(6);
    if (IN(7)) { moe_tables(F, true); gather_phase(F);
#if DBG_REP == 11
        xcd_barrier(bar); moe_tables(F, true); gather_phase(F);
#endif
    }
    SEAM(7);
    if (IN(8)) {
        moe_tables(F, false);
        MoeOrder<2> S; S.init(ws + WS_XN, DM / 2, ws + WS_WGU, DM / 2, (size_t)4096 * DM, (const LAS int*)(F.lds + MISC_OFF) + 128, (int)F.MISC[48], G, c);
        S.rtok = (const int*)(ws + WS_XG);
        EpiGU E{ws + WS_ACT, F.in[I_BGU]};
        pg8::gemm_phase<true, EpiGU, MoeOrder<2>, false, true>(F.lds, pg8::Geo{DM / 2, DM / 2, DM / 2}, S, E);
#if DBG_REP == 8
        { xcd_barrier(bar); EpiGU E2{ws + WS_Y, F.in[I_BGU]}; pg8::gemm_phase<true, EpiGU, MoeOrder<2>, false, true>(F.lds, pg8::Geo{DM / 2, DM / 2, DM / 2}, S, E2); }
#endif
#if DBG_REP == 15
        { xcd_barrier(bar); EpiNull E2{ws + WS_Y}; pg8::gemm_phase<true, EpiNull, MoeOrder<2>, false, true>(F.lds, pg8::Geo{DM / 2, DM / 2, DM / 2}, S, E2); }
#endif
    }
    SEAM(8);
    if (IN(9)) {
        moe_tables(F, false);
        MoeOrder<1> S; S.init(ws + WS_ACT, DEXP / 2, ws + WS_WDN, DEXP / 2, (size_t)DM * DEXP, (const LAS int*)(F.lds + MISC_OFF) + 128, (int)F.MISC[48], G, c);
        EpiDN E{ws + WS_Y, F.in[I_BDN]};
        pg8::gemm_phase<true>(F.lds, pg8::Geo{DEXP / 2, DEXP / 2, DEXP / 2}, S, E);
#if DBG_REP == 9
        xcd_barrier(bar); pg8::gemm_phase<true>(F.lds, pg8::Geo{DEXP / 2, DEXP / 2, DEXP / 2}, S, E);
#endif
    }
    SEAM(9);
#if DBG_REP == 12
    for (int rb_ = 0; rb_ < 10; ++rb_) xcd_barrier(bar);
#endif
#if DBG_REP == 13
    if (IN(2)) { pg8::DenseOrder S; S.init(ws + WS_PROJ + (size_t)PC_QA * 2, NPROJ, ws + WS_WQB, Q_LORA, NT, MLA_H * QKD, G, c);
          EpiQB E{(bf16*)(ws + WS_Q), (const float*)(ws + WS_SSP), (const float*)(ws + WS_ROPE)};
          pg8::gemm_phase<false>(F.lds, pg8::Geo{NPROJ, Q_LORA, Q_LORA}, S, E);
          pg8::DenseOrder S2; S2.init(ws + WS_PROJ + (size_t)PC_KVA * 2, NPROJ, ws + WS_WKVB, KV_LORA, NT, MLA_H * 256, G, c);
          EpiKVB E2{(bf16*)(ws + WS_KN), (bf16*)(ws + WS_V), (const float*)(ws + WS_SSP)};
          pg8::gemm_phase<false>(F.lds, pg8::Geo{NPROJ, KV_LORA, KV_LORA}, S2, E2); xcd_barrier(bar); }
#endif
    if (IN(10)) { final_phase(F);
#if DBG_REP == 5
        xcd_barrier(bar); final_phase(F);
#endif
    }
#undef IN
#undef SEAM
}

extern "C" void kernel_launch(void* const* d_in, const int* in_sizes, int n_in, void* d_out, int out_size, void* d_ws, size_t ws_size, hipStream_t stream) {
    static int grid = 0;
    if (grid == 0) {
        if (n_in != 26 || in_sizes[0] != NT * DM || out_size != NT * DM || ws_size < WS_END) { fprintf(stderr, "kernel_launch: unexpected shapes (n_in %d, in0 %d, out %d, ws %zu < %zu)\n", n_in, n_in > 0 ? in_sizes[0] : -1, out_size, ws_size, (size_t)WS_END); grid = -1; return; }
        int dev = 0, cus = 0, per_cu = 0;
        if (hipGetDevice(&dev) != hipSuccess || hipDeviceGetAttribute(&cus, hipDeviceAttributeMultiprocessorCount, dev) != hipSuccess) { grid = -1; return; }
        if (hipFuncSetAttribute((const void*)hymba_fwd, hipFuncAttributeMaxDynamicSharedMemorySize, LDS_BYTES) != hipSuccess) { fprintf(stderr, "kernel_launch: hipFuncSetAttribute failed\n"); grid = -1; return; }
        if (hipOccupancyMaxActiveBlocksPerMultiprocessor(&per_cu, (const void*)hymba_fwd, NWAVES * 64, LDS_BYTES) != hipSuccess || per_cu < 1) { fprintf(stderr, "kernel_launch: occupancy query says %d blocks per CU\n", per_cu); }
        (void)hipGetLastError();
        grid = cus;
        if (grid % 8 != 0) { fprintf(stderr, "kernel_launch: grid %d is not a multiple of 8\n", grid); grid = -1; return; }
    }
    if (grid < 0) return;
    if (hipMemsetAsync((char*)d_ws + WS_CTL, 0, CTL_ZERO_BYTES, stream) != hipSuccess) return;
    Args a{};
    for (int i = 0; i < 26; ++i) a.in[i] = (const float*)d_in[i];
    a.out = (float*)d_out; a.ws = (unsigned char*)d_ws;
#if MK_N_LAUNCHES == 1
    a.ph_lo = 0; a.ph_hi = NPHASE;
    hipLaunchKernelGGL(hymba_fwd, dim3(grid), dim3(NWAVES * 64), LDS_BYTES, stream, a);
#else
    for (int p = 0; p < NPHASE; ++p) { a.ph_lo = p; a.ph_hi = p + 1; hipLaunchKernelGGL(hymba_fwd, dim3(grid), dim3(NWAVES * 64), LDS_BYTES, stream, a); }
#endif
    const hipError_t le = hipPeekAtLastError();
    if (le != hipSuccess) fprintf(stderr, "kernel_launch: launch failed: %s\n", hipGetErrorName(le));
}
```

```cpp
#include <hip/hip_runtime.h>
#include <cstdio>
#include <cstdint>

#ifndef MK_N_LAUNCHES
#define MK_N_LAUNCHES 1
#endif
#ifndef DBG_PROBE
#define DBG_PROBE 0
#define DBG_PROBE_F32 0
#define DBG_PROBE_OFF WS_YCAT
#define DBG_PROBE_LD 2048
#endif
#ifndef DBG_REP
#define DBG_REP 0
#endif
#ifndef DBG_REP0
#define DBG_REP0 0
#endif
#ifndef DBG_REP8
#define DBG_REP8 0
#endif
#ifndef DBG_NO_SSM
#define DBG_NO_SSM 0
#endif
#ifndef DBG_NO_ATT
#define DBG_NO_ATT 0
#endif
#ifndef DBG_NO_MOE
#define DBG_NO_MOE 0
#endif

constexpr int BATCH = 4, SEQ = 4096, NT = BATCH * SEQ, DM = 2048;
constexpr int D_SSM = 1024, SSM_HEADS = 16, HDIM = 64, NGRP = 2, DSTATE = 128, CHUNK = 128, NCHUNK = SEQ / CHUNK;
constexpr int CONV_DIM = 1536;
constexpr int MLA_H = 8, QK_NOPE = 128, QK_ROPE = 64, QKD = 192, VD = 128, Q_LORA = 768, KV_LORA = 512;
constexpr int IN_PROJ = 3936, NPROJ = 3840  , NIN_PAD = 4096;
constexpr int NEXP = 32, TOPK = 4, DEXP = 2048;
constexpr float RMS_EPS = 1e-6f;
constexpr int MAX_TILES = 288, MAX_ROWS = MAX_TILES * 256;
constexpr int NPHASE = 11;

constexpr int PC_Z = 0, PC_XS = 1024, PC_B = 2048, PC_C = 2304, PC_QA = 2560, PC_KVA = 3328;

constexpr size_t MiB = 1u << 20;
constexpr size_t WS_CTL = 0, CTL_ZERO_BYTES = 1 * MiB;
constexpr size_t WS_WIN = 1 * MiB;
constexpr size_t WS_WQB = 17 * MiB;
constexpr size_t WS_WKVB = 20 * MiB;
constexpr size_t WS_WOUT = 22 * MiB;
constexpr size_t WS_ROPE = 30 * MiB;
constexpr size_t WS_DT = 34 * MiB;
constexpr size_t WS_DTA = 36 * MiB;
constexpr size_t WS_CD = 40 * MiB;
constexpr size_t WS_KPE = 41 * MiB;
constexpr size_t WS_TOKE = 43 * MiB;
constexpr size_t WS_TOKP = WS_TOKE + 256 * 1024;
constexpr size_t WS_TOKG = WS_TOKE + 512 * 1024;
constexpr size_t WS_TOKR = WS_TOKE + 768 * 1024;
constexpr size_t WS_RTS = 44 * MiB;
constexpr size_t WS_WRT = 46 * MiB;
constexpr size_t WS_SSP = 47 * MiB;
constexpr size_t WS_SS2P = 49 * MiB;
constexpr size_t WS_XN = 64 * MiB;
constexpr size_t WS_PROJ = 128 * MiB;
constexpr size_t WS_Q = 256 * MiB;
constexpr size_t WS_KN = 304 * MiB;
constexpr size_t WS_V = 336 * MiB;
constexpr size_t WS_O = 368 * MiB;
constexpr size_t WS_XT = 432 * MiB;
constexpr size_t WS_BC = 464 * MiB;
constexpr size_t WS_ST = 480 * MiB;
constexpr size_t WS_YCAT = 608 * MiB;
constexpr size_t WS_H = 672 * MiB;
constexpr size_t WS_XG = 800 * MiB;
constexpr size_t WS_ACT = 1088 * MiB;
constexpr size_t WS_Y = 1376 * MiB;
constexpr size_t WS_WGU = 1664 * MiB;
constexpr size_t WS_WDN = 2176 * MiB;
constexpr size_t WS_END = 2432 * MiB;
constexpr int CW_BAR = 4096;
constexpr int CW_CNT = 8192;

constexpr int RING_BYTES = 131072;
constexpr int MISC_OFF = RING_BYTES;
constexpr int LDS_BYTES = 147456;
constexpr int NWAVES = 8;

#define GAS __attribute__((address_space(1)))
#define LAS __attribute__((address_space(3)))
typedef unsigned short bf16;
typedef unsigned v4u __attribute__((ext_vector_type(4)));
typedef unsigned v2u __attribute__((ext_vector_type(2)));
typedef float f32x4 __attribute__((ext_vector_type(4)));
typedef float f32x2 __attribute__((ext_vector_type(2)));
typedef float f32x16 __attribute__((ext_vector_type(16)));
typedef short bf16x8 __attribute__((ext_vector_type(8)));
typedef short s16x4 __attribute__((ext_vector_type(4)));
typedef GAS unsigned gu32;
#define RLX_AGENT __ATOMIC_RELAXED, __HIP_MEMORY_SCOPE_AGENT
#define LDS_WAIT() asm volatile("s_waitcnt lgkmcnt(0)" ::: "memory")
#define VM_WAIT() asm volatile("s_waitcnt vmcnt(0)" ::: "memory")

typedef __bf16 bfx2_t __attribute__((ext_vector_type(2)));
__device__ __forceinline__ unsigned cvt_pk_bf16(float lo, float hi) { const f32x2 v = {lo, hi}; const bfx2_t r = __builtin_convertvector(v, bfx2_t); return __builtin_bit_cast(unsigned, r); }
__device__ __forceinline__ float bf_lo(unsigned u) { return __uint_as_float(u << 16); }
__device__ __forceinline__ float bf_hi(unsigned u) { return __uint_as_float(u & 0xffff0000u); }
__device__ __forceinline__ float wave_sum(float v) {
#pragma unroll
    for (int o = 1; o < 64; o <<= 1) v += __shfl_xor(v, o);
    return v;
}
__device__ __forceinline__ float silu_f(float v) { return v * __builtin_amdgcn_rcpf(1.f + __expf(-v)); }

#define XB_TMO      128
#define XB_XCNT(j)  (256  + 64 * (j))
#define XB_XSUB(j)  (1280 + 64 * (j))
#define XB_XGEN(j)  (2304 + 64 * (j))
#define XB_TOP      3328
#define XB_TOPGEN   3392
#define XCD_BAR_WORDS 3456
#define XB_SPIN_CAP (1u << 18)

__device__ __forceinline__ unsigned xb_ld(unsigned* p)              { return __hip_atomic_load(p, __ATOMIC_RELAXED, __HIP_MEMORY_SCOPE_AGENT); }
__device__ __forceinline__ unsigned xb_add(unsigned* p, unsigned v) { return __hip_atomic_fetch_add(p, v, __ATOMIC_RELAXED, __HIP_MEMORY_SCOPE_AGENT); }
__device__ __forceinline__ unsigned xb_xcc_id() { return (unsigned)__builtin_amdgcn_s_getreg((3 << 11) | 20) & 0xFu; }
#define XB_SPIN(cond, bar) do { unsigned _sp = 0; while (cond) { __builtin_amdgcn_s_sleep(1); \
    if ((++_sp & 255u) == 0u) { if (xb_ld(&(bar)[XB_TMO])) break; if (_sp > XB_SPIN_CAP) { atomicAdd(&(bar)[XB_TMO], 1u); break; } } } } while (0)

struct XcdBarrier { unsigned* bar; unsigned x; volatile LAS unsigned* st; };

__device__ __forceinline__ XcdBarrier xcd_barrier_post(unsigned* bar, volatile LAS unsigned* st) {
    XcdBarrier b; b.bar = bar; b.x = xb_xcc_id(); b.st = st;
    if (threadIdx.x == 0) (void)xb_add(&bar[XB_XCNT(b.x)], 1u);
    return b;
}
__device__ __forceinline__ void xcd_barrier_complete(unsigned* bar, unsigned x, unsigned& nloc, unsigned& nx) {
    const unsigned G = gridDim.x * gridDim.y * gridDim.z;
    unsigned sum, cnt, mine, sp = 0u;
    for (;;) {
        sum = 0u; cnt = 0u; mine = 0u;
#pragma unroll
        for (unsigned j = 0; j < 16; ++j) { const unsigned c = xb_ld(&bar[XB_XCNT(j)]); sum += c; cnt += (c > 0u) ? 1u : 0u; mine = (j == x) ? c : mine; }
        if (sum == G) break;
        __builtin_amdgcn_s_sleep(1);
        if ((++sp & 255u) == 0u) { if (xb_ld(&bar[XB_TMO])) break; if (sp > XB_SPIN_CAP) { atomicAdd(&bar[XB_TMO], 1u); break; } }
    }
    nloc = mine > 0u ? mine : 1u; nx = cnt > 0u ? cnt : 1u;
}
__device__ __forceinline__ void xcd_barrier(const XcdBarrier& b) {
    asm volatile("s_waitcnt vmcnt(0)" ::: "memory");
    __syncthreads();
    if (threadIdx.x == 0) {
        unsigned* bar = b.bar;
        __builtin_amdgcn_s_waitcnt(0);
        unsigned nloc = b.st[0], nx = b.st[1];
        if (nloc == 0u) { xcd_barrier_complete(bar, b.x, nloc, nx); b.st[0] = nloc; b.st[1] = nx; }
        const unsigned old = xb_add(&bar[XB_XSUB(b.x)], 1u);
        const unsigned gen = old / nloc;
        if (old + 1u == (gen + 1u) * nloc) {
            __builtin_amdgcn_fence(__ATOMIC_RELEASE, "agent");
            asm volatile("s_waitcnt vmcnt(0)" ::: "memory");
            const unsigned og = xb_add(&bar[XB_TOP], 1u);
            const unsigned tg = og / nx;
            if (og + 1u == (tg + 1u) * nx) xb_add(&bar[XB_TOPGEN], 1u);
            else XB_SPIN(xb_ld(&bar[XB_TOPGEN]) == tg, bar);
            __builtin_amdgcn_fence(__ATOMIC_ACQUIRE, "agent");
            xb_add(&bar[XB_XGEN(b.x)], 1u);
            asm volatile("s_waitcnt vmcnt(0)" ::: "memory");
        } else {
            XB_SPIN(xb_ld(&bar[XB_XGEN(b.x)]) == gen, bar);
            __builtin_amdgcn_fence(__ATOMIC_ACQUIRE, "agent");
            asm volatile("s_waitcnt vmcnt(0)" ::: "memory");
        }
    }
    __syncthreads();
}

namespace pg8 {
constexpr int BM = 256, BK = 64, HALF = 128, HTB = HALF * BK * 2, STAGE_BYTES = 8 * HTB;
__device__ __forceinline__ int lds_byte(int r, int c) { const int st = (r >> 4) * 2 + (c >> 5), rr = r & 15, cc = c & 31, ob = rr * 64 + cc * 2; return st * 1024 + (ob ^ (((ob >> 9) & 1) << 5)); }
__device__ __forceinline__ void stage_rc(int b, int& R, int& C) { const int st = b / 1024, sb = b % 1024, swz = sb ^ (((sb >> 9) & 1) << 5); R = (st >> 1) * 16 + swz / 64; C = (st & 1) * 32 + (swz % 64) / 2; }
__device__ __forceinline__ int perm32(int rho) { const int n = rho >> 4, i = rho & 15; return 8 * (i >> 2) + 4 * n + (i & 3); }

typedef int v8i_t __attribute__((ext_vector_type(8)));
__device__ __forceinline__ v8i_t cat8(bf16x8 lo, bf16x8 hi) { const v4u a = __builtin_bit_cast(v4u, lo), b = __builtin_bit_cast(v4u, hi); return (v8i_t){(int)a.x, (int)a.y, (int)a.z, (int)a.w, (int)b.x, (int)b.y, (int)b.z, (int)b.w}; }
struct Unit { const char* A0; const char* B0; int pm, pn, e; };
struct Geo { int lda, ldb, K; };

template <bool FP8, class Epi, class Sched, bool BNT = false, bool GATHER = false>
__device__ __forceinline__ void gemm_phase(LAS unsigned char* lds, const Geo g, const Sched& S, const Epi& E) {
    const int tid = threadIdx.x, wid = __builtin_amdgcn_readfirstlane(tid >> 6), lane = tid & 63, wr = wid >> 2, wc = wid & 3, fr = lane & 15, fq = lane >> 4;
    const int K = g.K, nt = K / BK;
    unsigned voffA[2], voffB[2];
    unsigned voffC[2][2], voffN[2][2], cofs[2]; int rsel[2];
    constexpr bool PERM16 = FP8;
#pragma unroll
    for (int i = 0; i < 2; ++i) { int R, C; stage_rc(tid * 16 + i * 8192, R, C); const int p = perm32(R & 31);
        const int Rb = PERM16 ? (64 * (R >> 5) + p + (p & 24)) : ((R & ~31) + p);
        voffA[i] = (unsigned)(R * g.lda + C) * 2u; voffB[i] = (unsigned)(Rb * g.ldb + C) * 2u; cofs[i] = (unsigned)C * 2u; rsel[i] = R; }
    const size_t kstep = (size_t)(BK * 2);
    const size_t hstepA = (size_t)HALF * g.lda * 2, hstepB = (size_t)(PERM16 ? 8 : HALF) * g.ldb * 2;
    const unsigned ldsw = (unsigned)wid * 1024u;
    const int aoff = lds_byte(wr * 64 + fr, fq * 8), boff = lds_byte(wc * 32 + fr, fq * 8);
#define PG8_SA(b, h) (((b) * 2 + (h)) * HTB)
#define PG8_SB(b, h) ((4 + (b) * 2 + (h)) * HTB)
#define PG8_STAGE(bufoff, gbase, voff) do { _Pragma("unroll") for (int _i = 0; _i < 2; ++_i) \
        __builtin_amdgcn_global_load_lds((const unsigned*)((const char*)(gbase) + (voff)[_i]), (LAS unsigned*)(lds + (bufoff) + ldsw + _i * 8192), 16, 0, 0); } while (0)
#define PG8_STAGE_NT(bufoff, gbase, voff) do { _Pragma("unroll") for (int _i = 0; _i < 2; ++_i) \
        __builtin_amdgcn_global_load_lds((const unsigned*)((const char*)(gbase) + (voff)[_i]), (LAS unsigned*)(lds + (bufoff) + ldsw + _i * 8192), 16, 0, BNT ? 2 : 0); } while (0)
#define PG8_LD8(p) ({ const v4u lo_ = *(const LAS v4u*)(p), hi_ = *(const LAS v4u*)((p) + 1024); (v8i_t){(int)lo_.x, (int)lo_.y, (int)lo_.z, (int)lo_.w, (int)hi_.x, (int)hi_.y, (int)hi_.z, (int)hi_.w}; })
#define PG8_LDA(dst, b, h) do { if constexpr (FP8) { _Pragma("unroll") for (int m = 0; m < 4; ++m) dst##8[m] = PG8_LD8(lds + PG8_SA(b, h) + aoff + m * 2048); } \
        else { _Pragma("unroll") for (int m = 0; m < 4; ++m) _Pragma("unroll") for (int k = 0; k < 2; ++k) dst[m][k] = *(const LAS bf16x8*)(lds + PG8_SA(b, h) + aoff + m * 2048 + k * 1024); } } while (0)
#define PG8_LDB(dst, b, h) do { if constexpr (FP8) { _Pragma("unroll") for (int n = 0; n < 2; ++n) dst##8[n] = PG8_LD8(lds + PG8_SB(b, h) + boff + n * 2048); } \
        else { _Pragma("unroll") for (int n = 0; n < 2; ++n) _Pragma("unroll") for (int k = 0; k < 2; ++k) dst[n][k] = *(const LAS bf16x8*)(lds + PG8_SB(b, h) + boff + n * 2048 + k * 1024); } } while (0)
#define PG8_MMA(ai, bj, At, Bt) do { if constexpr (!FP8) __builtin_amdgcn_s_setprio(1); \
        if constexpr (FP8) { _Pragma("unroll") for (int m = 0; m < 4; ++m) _Pragma("unroll") for (int n = 0; n < 2; ++n) \
            asm volatile("v_mfma_f32_16x16x128_f8f6f4 %0, %1, %2, %0" : "+v"(acc[ai][bj][m][n]) : "v"(Bt##8[n]), "v"(At##8[m])); } \
        else { _Pragma("unroll") for (int m = 0; m < 4; ++m) _Pragma("unroll") for (int n = 0; n < 2; ++n) _Pragma("unroll") for (int k = 0; k < 2; ++k) \
            acc[ai][bj][m][n] = __builtin_amdgcn_mfma_f32_16x16x32_bf16(Bt[n][k], At[m][k], acc[ai][bj][m][n], 0, 0, 0); } \
        if constexpr (!FP8) __builtin_amdgcn_s_setprio(0); } while (0)
#define PG8_AOFF(h, nx) (GATHER ? ((nx) ? voffN[h] : voffC[h]) : voffA)
#define PG8_AH(h) (GATHER ? (size_t)0 : (size_t)(h) * hstepA)
#define PG8_WAIT_V(n) asm volatile("s_waitcnt vmcnt(" #n ")" ::: "memory")
#define PG8_WAIT_L(n) asm volatile("s_waitcnt lgkmcnt(" #n ")" ::: "memory")
#define PG8_BAR __builtin_amdgcn_s_barrier()
#define PG8_SCHED __builtin_amdgcn_sched_barrier(0)
    Unit cur, nxt; int ui = 0;
    if (!S.next(0, cur)) return;
    f32x4 acc[2][2][4][2];
#pragma unroll
    for (int a = 0; a < 2; ++a)
#pragma unroll
        for (int b = 0; b < 2; ++b)
#pragma unroll
            for (int m = 0; m < 4; ++m)
#pragma unroll
                for (int n = 0; n < 2; ++n) acc[a][b][m][n] = (f32x4){0.f, 0.f, 0.f, 0.f};
    bf16x8 At[4][2], B0[2][2], B1[2][2]; v8i_t At8[4], B08[2], B18[2];
    const char* cA = cur.A0; const char* cB = cur.B0;
    if constexpr (GATHER) { const int* rt = S.rowtab(cur);
#pragma unroll
        for (int h = 0; h < 2; ++h)
#pragma unroll
            for (int i = 0; i < 2; ++i) voffC[h][i] = (unsigned)rt[h * HALF + rsel[i]] * (unsigned)(g.lda * 2) + cofs[i]; }
    PG8_STAGE_NT(PG8_SB(0, 0), cB, voffB); PG8_STAGE(PG8_SA(0, 0), cA + PG8_AH(0), PG8_AOFF(0, false)); PG8_STAGE_NT(PG8_SB(0, 1), cB + hstepB, voffB); PG8_STAGE(PG8_SA(0, 1), cA + PG8_AH(1), PG8_AOFF(1, false));
    if (wr == 1) PG8_BAR;
    PG8_WAIT_V(4); PG8_BAR;
    PG8_STAGE_NT(PG8_SB(1, 0), cB + kstep, voffB); PG8_STAGE(PG8_SA(1, 0), cA + kstep + PG8_AH(0), PG8_AOFF(0, false)); PG8_STAGE_NT(PG8_SB(1, 1), cB + hstepB + kstep, voffB);
    PG8_WAIT_V(6); PG8_BAR;
    for (;;) {
        const bool has_next = S.next(ui + 1, nxt);
        if constexpr (GATHER) { if (has_next) { const int* rt = S.rowtab(nxt);
#pragma unroll
            for (int h = 0; h < 2; ++h)
#pragma unroll
                for (int i = 0; i < 2; ++i) asm volatile("global_load_dword %0, %1, off" : "=v"(voffN[h][i]) : "v"(rt + h * HALF + rsel[i]) : "memory"); } }
        const auto pf = E.prefetch(cur, wr, wc, fr, fq);
        const char* nA = has_next ? nxt.A0 : cA; const char* nB = has_next ? nxt.B0 : cB;
        for (int t = 0; t < nt; t += 2) {
            const bool last = (t == nt - 2);
            const char* a1 = cA + (size_t)(t + 1) * kstep;
            const char* a2 = last ? nA : cA + (size_t)(t + 2) * kstep; const char* b2 = last ? nB : cB + (size_t)(t + 2) * kstep;
            const char* a3 = a2 + kstep; const char* b3 = b2 + kstep;
            const bool nxf = last && has_next;
            if constexpr (GATHER) { if (nxf) {
#pragma unroll
                for (int h = 0; h < 2; ++h)
#pragma unroll
                    for (int i = 0; i < 2; ++i) voffN[h][i] = voffN[h][i] * (unsigned)(g.lda * 2) + cofs[i]; } }
            PG8_LDB(B0, 0, 0); PG8_SCHED; PG8_LDA(At, 0, 0); PG8_STAGE(PG8_SA(1, 1), a1 + PG8_AH(1), PG8_AOFF(1, false));
            PG8_WAIT_L(8); PG8_BAR; PG8_WAIT_L(0); PG8_MMA(0, 0, At, B0); PG8_BAR; PG8_SCHED;
            PG8_LDB(B1, 0, 1); PG8_STAGE_NT(PG8_SB(0, 0), b2, voffB);
            PG8_BAR; PG8_WAIT_L(0); PG8_MMA(0, 1, At, B1); PG8_BAR;
            PG8_LDA(At, 0, 1); PG8_STAGE(PG8_SA(0, 0), a2 + PG8_AH(0), PG8_AOFF(0, nxf));
            PG8_BAR; PG8_WAIT_L(0); PG8_MMA(1, 0, At, B0); PG8_BAR; PG8_SCHED;
            PG8_STAGE_NT(PG8_SB(0, 1), b2 + hstepB, voffB);
            PG8_WAIT_V(6); PG8_BAR; PG8_MMA(1, 1, At, B1); PG8_BAR;
            PG8_LDB(B0, 1, 0); PG8_SCHED; PG8_LDA(At, 1, 0); PG8_STAGE(PG8_SA(0, 1), a2 + PG8_AH(1), PG8_AOFF(1, nxf));
            PG8_WAIT_L(8); PG8_BAR; PG8_WAIT_L(0); PG8_MMA(0, 0, At, B0); PG8_BAR; PG8_SCHED;
            PG8_LDB(B1, 1, 1); PG8_STAGE_NT(PG8_SB(1, 0), b3, voffB);
            PG8_BAR; PG8_WAIT_L(0); PG8_MMA(0, 1, At, B1); PG8_BAR;
            PG8_LDA(At, 1, 1); PG8_STAGE(PG8_SA(1, 0), a3 + PG8_AH(0), PG8_AOFF(0, nxf));
            PG8_BAR; PG8_WAIT_L(0); PG8_MMA(1, 0, At, B0); PG8_BAR; PG8_SCHED;
            PG8_STAGE_NT(PG8_SB(1, 1), b3 + hstepB, voffB);
            PG8_WAIT_V(6); PG8_BAR; PG8_MMA(1, 1, At, B1); PG8_BAR;
        }
        if constexpr (FP8) asm volatile("s_nop 15\n\ts_nop 15" ::: "memory");
        E(acc, cur, wr, wc, fr, fq, pf);
        if (!has_next) break;
#pragma unroll
        for (int a = 0; a < 2; ++a)
#pragma unroll
            for (int b = 0; b < 2; ++b)
#pragma unroll
                for (int m = 0; m < 4; ++m)
#pragma unroll
                    for (int n = 0; n < 2; ++n) acc[a][b][m][n] = (f32x4){0.f, 0.f, 0.f, 0.f};
        cur = nxt; cA = nA; cB = nB; ++ui;
        if constexpr (GATHER) {
#pragma unroll
            for (int h = 0; h < 2; ++h)
#pragma unroll
                for (int i = 0; i < 2; ++i) voffC[h][i] = voffN[h][i]; }
    }
    PG8_WAIT_V(0);
    if (wr == 0) PG8_BAR;
    PG8_BAR;
#undef PG8_SA
#undef PG8_SB
#undef PG8_STAGE
#undef PG8_STAGE_NT
#undef PG8_LDA
#undef PG8_LDB
#undef PG8_MMA
#undef PG8_WAIT_V
#undef PG8_AOFF
#undef PG8_AH
#undef PG8_WAIT_L
#undef PG8_BAR
#undef PG8_SCHED
}

struct DenseOrder {
    const char* A; const char* Bt; size_t tstepA, tstepB; int nM, nN, nwg, G, c;
    __device__ void init(const void* A_, int lda, const void* Bt_, int ldb, int M, int N, int G_, int c_) {
        A = (const char*)A_; Bt = (const char*)Bt_; tstepA = (size_t)BM * lda * 2; tstepB = (size_t)BM * ldb * 2; nM = M / BM; nN = N / BM; nwg = nM * nN; G = G_; c = c_; }
    int skew = 0;
    __device__ bool next(int i, Unit& u) const {
        long L = (long)i * G + c;
        if (skew) { const int hG = G >> 1; if (c < hG) { if (i > 0) return false; L = c; } else { if (i > 2) return false; L = (i == 0) ? c : (c + hG * i); } }
        if (L >= nwg) return false;
        int wgid = (int)L; { const int q = nwg / 8, r = nwg % 8, xcd = wgid % 8, off = wgid / 8; wgid = (xcd < r ? xcd * (q + 1) : r * (q + 1) + (xcd - r) * q) + off; }
        const int nig = 8 * nN, gid = wgid / nig, fm = gid * 8, gsz = (nM - fm) < 8 ? (nM - fm) : 8;
        u.pm = fm + ((wgid % nig) % gsz); u.pn = (wgid % nig) / gsz; u.e = 0;
        u.A0 = A + (size_t)u.pm * tstepA; u.B0 = Bt + (size_t)u.pn * tstepB; return true;
    }
};
}

typedef const f32x4 (&AccRef)[2][2][4][2];
struct NoPf {};
struct BiasPf { f32x4 bv[2][2]; };
struct RsPf { float rs[2][4]; };
__device__ __forceinline__ v4u pack8(f32x4 v0, f32x4 v1) { v4u w; w.x = cvt_pk_bf16(v0[0], v0[1]); w.y = cvt_pk_bf16(v0[2], v0[3]); w.z = cvt_pk_bf16(v1[0], v1[1]); w.w = cvt_pk_bf16(v1[2], v1[3]); return w; }
__device__ __forceinline__ void rope4(f32x4& v0, f32x4& v1, const float* cs  ) {
    const f32x4 a = *(const f32x4*)cs, b = *(const f32x4*)(cs + 4);
    float t1, t2;
    t1 = v0[0]; t2 = v0[1]; v0[0] = t1 * a[0] - t2 * a[1]; v0[1] = t2 * a[0] + t1 * a[1];
    t1 = v0[2]; t2 = v0[3]; v0[2] = t1 * a[2] - t2 * a[3]; v0[3] = t2 * a[2] + t1 * a[3];
    t1 = v1[0]; t2 = v1[1]; v1[0] = t1 * b[0] - t2 * b[1]; v1[1] = t2 * b[0] + t1 * b[1];
    t1 = v1[2]; t2 = v1[3]; v1[2] = t1 * b[2] - t2 * b[3]; v1[3] = t2 * b[2] + t1 * b[3];
}

struct EpiInProj {
    bf16* PROJ; bf16* KPE; float* DT; float* ssp; const float* rope;
    __device__ __forceinline__ NoPf prefetch(const pg8::Unit&, int, int, int, int) const { return NoPf{}; }
    __device__ __forceinline__ void operator()(AccRef acc, const pg8::Unit& u, int wr, int wc, int fr, int fq, const NoPf&) const {
        const int row0 = u.pm * 256 + wr * 64 + fr;
        if (u.pn < 15) {
            const int col0 = u.pn * 256 + wc * 32 + 8 * fq;
            const bool wss = u.pn >= 10;
#pragma unroll
            for (int ai = 0; ai < 2; ++ai)
#pragma unroll
                for (int m = 0; m < 4; ++m) {
                    const int row = row0 + ai * 128 + m * 16; float s = 0.f;
#pragma unroll
                    for (int bj = 0; bj < 2; ++bj) {
                        const f32x4 v0 = acc[ai][bj][m][0], v1 = acc[ai][bj][m][1];
                        *(v4u*)(PROJ + (size_t)row * NPROJ + col0 + bj * 128) = pack8(v0, v1);
                        s += v0[0] * v0[0] + v0[1] * v0[1] + v0[2] * v0[2] + v0[3] * v0[3] + v1[0] * v1[0] + v1[1] * v1[1] + v1[2] * v1[2] + v1[3] * v1[3];
                    }
                    if (wss) { s += __shfl_xor(s, 16); s += __shfl_xor(s, 32); if (fq == 0) ssp[(size_t)row * 20 + (u.pn - 10) * 4 + wc] = s; }
                }
        } else {
            if (wc < 2) {
#pragma unroll
                for (int ai = 0; ai < 2; ++ai)
#pragma unroll
                    for (int m = 0; m < 4; ++m) {
                        const int row = row0 + ai * 128 + m * 16;
                        f32x4 v0 = acc[ai][0][m][0], v1 = acc[ai][0][m][1];
                        rope4(v0, v1, rope + (size_t)row * 64 + 2 * (16 * wc + 4 * fq));
                        *(v4u*)(KPE + (size_t)row * 64 + 32 * wc + 8 * fq) = pack8(v0, v1);
                    }
            } else if (wc == 2) {
#pragma unroll
                for (int ai = 0; ai < 2; ++ai)
#pragma unroll
                    for (int m = 0; m < 4; ++m) {
                        const int row = row0 + ai * 128 + m * 16;
                        *(f32x4*)(DT + (size_t)row * 32 + 8 * fq) = acc[ai][0][m][0];
                        *(f32x4*)(DT + (size_t)row * 32 + 8 * fq + 4) = acc[ai][0][m][1];
                    }
            }
        }
    }
};

struct EpiQB {
    bf16* Q; const float* ssp; const float* rope;
    __device__ __forceinline__ NoPf prefetch(const pg8::Unit&, int, int, int, int) const { return NoPf{}; }
    __device__ __forceinline__ void operator()(AccRef acc, const pg8::Unit& u, int wr, int wc, int fr, int fq, const NoPf&) const {
        const int row0 = u.pm * 256 + wr * 64 + fr;
        float rs[2][4];
        { f32x4 pv[2][4];
#pragma unroll
          for (int ai = 0; ai < 2; ++ai)
#pragma unroll
              for (int m = 0; m < 4; ++m) pv[ai][m] = *(const f32x4*)(ssp + (size_t)(row0 + ai * 128 + m * 16) * 20 + 4 * (fq < 3 ? fq : 0));
#pragma unroll
          for (int ai = 0; ai < 2; ++ai)
#pragma unroll
              for (int m = 0; m < 4; ++m) { float t = (fq < 3) ? ((pv[ai][m][0] + pv[ai][m][1]) + (pv[ai][m][2] + pv[ai][m][3])) : 0.f; t += __shfl_xor(t, 16); t += __shfl_xor(t, 32);
                  rs[ai][m] = rsqrtf(t * (1.f / Q_LORA) + RMS_EPS); } }
#pragma unroll
        for (int bj = 0; bj < 2; ++bj) {
            const int col = u.pn * 256 + bj * 128 + wc * 32 + 8 * fq, h = col / QKD, d = col - h * QKD; const bool rp = d >= QK_NOPE;
#pragma unroll
            for (int ai = 0; ai < 2; ++ai) {
                f32x4 ra[4], rb[4];
#pragma unroll
                for (int m = 0; m < 4; ++m) { const float* cs = rope + (size_t)(row0 + ai * 128 + m * 16) * 64 + (rp ? d - QK_NOPE : 0);
                    if (rp) { ra[m] = *(const f32x4*)cs; rb[m] = *(const f32x4*)(cs + 4); } else { ra[m] = (f32x4){1.f, 0.f, 1.f, 0.f}; rb[m] = (f32x4){1.f, 0.f, 1.f, 0.f}; } }
#pragma unroll
                for (int m = 0; m < 4; ++m) {
                    const int row = row0 + ai * 128 + m * 16, b = row >> 12, s = row & (SEQ - 1);
                    f32x4 v0 = acc[ai][bj][m][0] * rs[ai][m], v1 = acc[ai][bj][m][1] * rs[ai][m];
                    if (rp) { const f32x4 a = ra[m], c = rb[m]; float t1, t2;
                        t1 = v0[0]; t2 = v0[1]; v0[0] = t1 * a[0] - t2 * a[1]; v0[1] = t2 * a[0] + t1 * a[1];
                        t1 = v0[2]; t2 = v0[3]; v0[2] = t1 * a[2] - t2 * a[3]; v0[3] = t2 * a[2] + t1 * a[3];
                        t1 = v1[0]; t2 = v1[1]; v1[0] = t1 * c[0] - t2 * c[1]; v1[1] = t2 * c[0] + t1 * c[1];
                        t1 = v1[2]; t2 = v1[3]; v1[2] = t1 * c[2] - t2 * c[3]; v1[3] = t2 * c[2] + t1 * c[3]; }
                    *(v4u*)(Q + ((size_t)((b * MLA_H + h) * SEQ + s)) * QKD + d) = pack8(v0, v1);
                }
            }
        }
    }
};

struct EpiKVB {
    bf16* KN; bf16* V; const float* ssp;
    __device__ __forceinline__ NoPf prefetch(const pg8::Unit&, int, int, int, int) const { return NoPf{}; }
    __device__ __forceinline__ void operator()(AccRef acc, const pg8::Unit& u, int wr, int wc, int fr, int fq, const NoPf&) const {
        const int row0 = u.pm * 256 + wr * 64 + fr, d = wc * 32 + 8 * fq, h = u.pn;
        float rs[2][4];
        { f32x4 pv[2][4];
#pragma unroll
          for (int ai = 0; ai < 2; ++ai)
#pragma unroll
              for (int m = 0; m < 4; ++m) pv[ai][m] = *(const f32x4*)(ssp + (size_t)(row0 + ai * 128 + m * 16) * 20 + 12 + 4 * (fq >> 1));
#pragma unroll
          for (int ai = 0; ai < 2; ++ai)
#pragma unroll
              for (int m = 0; m < 4; ++m) { float t = (pv[ai][m][0] + pv[ai][m][1]) + (pv[ai][m][2] + pv[ai][m][3]); t += __shfl_xor(t, 32);
                  rs[ai][m] = rsqrtf(t * (1.f / KV_LORA) + RMS_EPS); } }
#pragma unroll
        for (int ai = 0; ai < 2; ++ai)
#pragma unroll
            for (int m = 0; m < 4; ++m) {
                const int row = row0 + ai * 128 + m * 16, b = row >> 12, s = row & (SEQ - 1); const float r = rs[ai][m];
                const size_t o = ((size_t)((b * MLA_H + h) * SEQ + s)) * 128 + d;
                *(v4u*)(KN + o) = pack8(acc[ai][0][m][0] * r, acc[ai][0][m][1] * r);
                *(v4u*)(V + o) = pack8(acc[ai][1][m][0] * r, acc[ai][1][m][1] * r);
            }
    }
};

struct EpiOut {
    const float* X; bf16* H; float* ss2p;
    __device__ __forceinline__ NoPf prefetch(const pg8::Unit&, int, int, int, int) const { return NoPf{}; }
    __device__ __forceinline__ void operator()(AccRef acc, const pg8::Unit& u, int wr, int wc, int fr, int fq, const NoPf&) const {
        const int row0 = u.pm * 256 + wr * 64 + fr, col0 = u.pn * 256 + wc * 32 + 8 * fq;
        f32x4 xb[3][4];
#define EPO_LOAD(g_) do { const float* xp_ = X + (size_t)(row0 + ((g_) >> 2) * 128 + ((g_) & 3) * 16) * DM + col0; \
        xb[(g_) % 3][0] = *(const f32x4*)xp_; xb[(g_) % 3][1] = *(const f32x4*)(xp_ + 4); xb[(g_) % 3][2] = *(const f32x4*)(xp_ + 128); xb[(g_) % 3][3] = *(const f32x4*)(xp_ + 132); } while (0)
        EPO_LOAD(0); EPO_LOAD(1);
#pragma unroll
        for (int g = 0; g < 8; ++g) { const int ai = g >> 2, m = g & 3;
            if (g + 2 < 8) EPO_LOAD(g + 2);
            const int row = row0 + ai * 128 + m * 16; float s = 0.f;
#pragma unroll
            for (int bj = 0; bj < 2; ++bj) {
                const size_t o = (size_t)row * DM + col0 + bj * 128;
                const f32x4 v0 = acc[ai][bj][m][0] + xb[g % 3][2 * bj], v1 = acc[ai][bj][m][1] + xb[g % 3][2 * bj + 1];
                *(v4u*)(H + o) = pack8(v0, v1);
                s += v0[0] * v0[0] + v0[1] * v0[1] + v0[2] * v0[2] + v0[3] * v0[3] + v1[0] * v1[0] + v1[1] * v1[1] + v1[2] * v1[2] + v1[3] * v1[3];
            }
            s += __shfl_xor(s, 16); s += __shfl_xor(s, 32); if (fq == 0) ss2p[(size_t)row * 32 + u.pn * 4 + wc] = s;
        }
#undef EPO_LOAD
    }
};

__device__ __forceinline__ float swiglu(float g, float l) {
    g = fminf(g, 7.f); l = fminf(fmaxf(l, -7.f), 7.f);
    return g * __builtin_amdgcn_rcpf(1.f + __expf(-1.702f * g)) * (l + 1.f);
}
__device__ __forceinline__ float sat8(float v) { return __builtin_amdgcn_fmed3f(v, -448.f, 448.f); }
__device__ __forceinline__ unsigned pk4_fp8(float a, float b, float c, float d) { int w = 0; w = __builtin_amdgcn_cvt_pk_fp8_f32(sat8(a), sat8(b), w, false); w = __builtin_amdgcn_cvt_pk_fp8_f32(sat8(c), sat8(d), w, true); return (unsigned)w; }
constexpr float W8_SCALE = 128.f, X8_SCALE = 16.f, A8_SCALE = 4.f;
static_assert(A8_SCALE == 4.f, "swiglu2 folds A8_SCALE = 4 into its last multiply");
__device__ __forceinline__ f32x2 swiglu2(f32x2 g, f32x2 l) {
    g = __builtin_elementwise_min(g, (f32x2){7.f, 7.f});
    l = __builtin_elementwise_min(__builtin_elementwise_max(l, (f32x2){-7.f, -7.f}), (f32x2){7.f, 7.f});
    const f32x2 t = g * (-1.702f * 1.4426950408889634f);
    f32x2 e; e[0] = __builtin_amdgcn_exp2f(t[0]); e[1] = __builtin_amdgcn_exp2f(t[1]);
    const f32x2 d = e + 1.f;
    f32x2 r; r[0] = __builtin_amdgcn_rcpf(d[0]); r[1] = __builtin_amdgcn_rcpf(d[1]);
    return (g * r) * (l * 4.f + 4.f);
}
struct EpiNull {
    unsigned char* D;
    __device__ __forceinline__ NoPf prefetch(const pg8::Unit&, int, int, int, int) const { return NoPf{}; }
    __device__ __forceinline__ void operator()(AccRef acc, const pg8::Unit& u, int wr, int wc, int fr, int fq, const NoPf&) const {
        f32x4 s = acc[0][0][0][0];
#pragma unroll
        for (int ai = 0; ai < 2; ++ai)
#pragma unroll
            for (int bj = 0; bj < 2; ++bj)
#pragma unroll
                for (int m = 0; m < 4; ++m) { s += acc[ai][bj][m][0]; s += acc[ai][bj][m][1]; }
        *(f32x4*)(D + ((size_t)(u.pm * 16 + u.pn) * 512 + threadIdx.x) * 16) = s; }
};
struct EpiGU {
    unsigned char* ACT; const float* bias;
    __device__ __forceinline__ BiasPf prefetch(const pg8::Unit& u, int wr, int wc, int fr, int fq) const { BiasPf p; const float* bp = bias + (size_t)u.e * 4096 + u.pn * 256 + wc * 64 + 16 * fq;
        asm volatile("global_load_dwordx4 %0, %4, off\n\tglobal_load_dwordx4 %1, %4, off offset:16\n\tglobal_load_dwordx4 %2, %4, off offset:32\n\tglobal_load_dwordx4 %3, %4, off offset:48"
                     : "=&v"(p.bv[0][0]), "=&v"(p.bv[0][1]), "=&v"(p.bv[1][0]), "=&v"(p.bv[1][1]) : "v"(bp) : "memory");
        return p; }
    __device__ __forceinline__ void operator()(AccRef acc, const pg8::Unit& u, int wr, int wc, int fr, int fq, const BiasPf& pfb) const {
        const int row0 = u.pm * 256 + wr * 64 + fr, col0 = u.pn * 256 + wc * 64 + 16 * fq;
        constexpr float SC = 1.f / (W8_SCALE * X8_SCALE);
        const auto& bv = pfb.bv;
#pragma unroll
        for (int ai = 0; ai < 2; ++ai)
#pragma unroll
            for (int m = 0; m < 4; ++m) {
                const int row = row0 + ai * 128 + m * 16; v2u w;
#pragma unroll
                for (int bj = 0; bj < 2; ++bj) {
                    const f32x4 v0 = acc[ai][bj][m][0] * SC + bv[bj][0], v1 = acc[ai][bj][m][1] * SC + bv[bj][1];
                    const f32x2 a = swiglu2((f32x2){v0[0], v0[2]}, (f32x2){v0[1], v0[3]}), b = swiglu2((f32x2){v1[0], v1[2]}, (f32x2){v1[1], v1[3]});
                    const unsigned q = pk4_fp8(a[0], a[1], b[0], b[1]); if (bj == 0) w.x = q; else w.y = q; }
                *(v2u*)(ACT + (size_t)row * DEXP + (col0 >> 1)) = w;
            }
    }
};
constexpr float Y8_SCALE = 16.f;
struct EpiDN {
    unsigned char* Y; const float* bias;
    __device__ __forceinline__ BiasPf prefetch(const pg8::Unit& u, int wr, int wc, int fr, int fq) const { BiasPf p; const float* bp = bias + (size_t)u.e * DM + u.pn * 256 + wc * 64 + 16 * fq;
        asm volatile("global_load_dwordx4 %0, %4, off\n\tglobal_load_dwordx4 %1, %4, off offset:16\n\tglobal_load_dwordx4 %2, %4, off offset:32\n\tglobal_load_dwordx4 %3, %4, off offset:48"
                     : "=&v"(p.bv[0][0]), "=&v"(p.bv[0][1]), "=&v"(p.bv[1][0]), "=&v"(p.bv[1][1]) : "v"(bp) : "memory");
        return p; }
    __device__ __forceinline__ void operator()(AccRef acc, const pg8::Unit& u, int wr, int wc, int fr, int fq, const BiasPf& pfb) const {
        const int row0 = u.pm * 256 + wr * 64 + fr, col0 = u.pn * 256 + wc * 64 + 16 * fq;
        const auto& bv = pfb.bv;
#pragma unroll
        for (int ai = 0; ai < 2; ++ai)
#pragma unroll
            for (int m = 0; m < 4; ++m) {
                const int row = row0 + ai * 128 + m * 16; v4u w;
#pragma unroll
                for (int bj = 0; bj < 2; ++bj) {
                    const f32x4 y0 = (acc[ai][bj][m][0] * (1.f / (W8_SCALE * A8_SCALE)) + bv[bj][0]) * Y8_SCALE, y1 = (acc[ai][bj][m][1] * (1.f / (W8_SCALE * A8_SCALE)) + bv[bj][1]) * Y8_SCALE;
                    const unsigned q0 = pk4_fp8(y0[0], y0[1], y0[2], y0[3]), q1 = pk4_fp8(y1[0], y1[1], y1[2], y1[3]);
                    if (bj == 0) { w.x = q0; w.y = q1; } else { w.z = q0; w.w = q1; } }
                *(v4u*)(Y + (size_t)row * DM + col0) = w;
            }
    }
};

template <int NPX>
struct MoeOrder {
    const char* A; const char* W; const LAS int* tile_e; size_t tstepA, tstepB, estep; int T, G8, x, q; const int* rtok = nullptr;
    __device__ void init(const void* A_, int lda, const void* W_, int ldb, size_t estep_bytes, const LAS int* te, int T_, int G, int c) {
        A = (const char*)A_; W = (const char*)W_; tile_e = te; tstepA = (size_t)256 * lda * 2; tstepB = (size_t)256 * ldb * 2; estep = estep_bytes; T = T_; G8 = G >> 3; x = c & 7; q = c >> 3; }
    __device__ bool next(int i, pg8::Unit& u) const {
        const int v = i * G8 + q, t = v / NPX, n = NPX * x + (v % NPX);
        if (t >= T) return false;
        const int e = __builtin_amdgcn_readfirstlane(tile_e[t]);
        u.pm = t; u.pn = n; u.e = e; u.A0 = rtok ? A : A + (size_t)t * tstepA; u.B0 = W + (size_t)e * estep + (size_t)n * tstepB; return true;
    }
    __device__ const int* rowtab(const pg8::Unit& u) const { return rtok + u.pm * 256; }
};

struct Frame {
    LAS unsigned char* lds;
    volatile LAS unsigned* MISC;
    gu32* ctl;
    int tid, lane, wave, G, c;
    unsigned char* ws;
    const float* in[26];
    float* out;
};
enum { I_X = 0, I_POS, I_NORM1, I_WIN, I_CONVW, I_CONVB, I_DTBF, I_DTBB, I_ALOGF, I_ALOGB, I_DSKIP, I_SSMNW, I_QANW, I_WQB, I_KVANW, I_WKVB, I_ATTNW, I_WOUT,
       I_NORM2, I_WR, I_BR, I_WGU, I_BGU, I_WDN, I_BDN, I_FNW };

template <class Map>
__device__ __forceinline__ void p0_transpose_item(const float* W, int N, bf16* WT, int ldt, const Map& map, const float* ks, LAS float* scr, int item, int lane) {
    const int nblk = N / 32, kb = item / nblk, nb = item % nblk, k0 = 64 * kb, n0 = 32 * nb, lr = lane >> 3, lq = lane & 7;
    f32x4 v[8];
#pragma unroll
    for (int i = 0; i < 8; ++i) v[i] = *(const f32x4*)(W + (size_t)(k0 + 8 * i + lr) * N + n0 + 4 * lq);
#pragma unroll
    for (int i = 0; i < 8; ++i) { const int k = 8 * i + lr; const float sc = ks ? ks[k0 + k] : 1.f; *(LAS f32x4*)(scr + k * 32 + 4 * (lq ^ ((k >> 3) & 7))) = v[i] * sc; }
    LDS_WAIT(); asm volatile("" ::: "memory");
    const int c = lq;
#pragma unroll
    for (int j = 0; j < 4; ++j) { const int n = lr + 8 * j; const LAS float* s = scr + (8 * c) * 32 + 4 * ((n >> 2) ^ c) + (n & 3);
        v4u o; o.x = cvt_pk_bf16(s[0 * 32], s[1 * 32]); o.y = cvt_pk_bf16(s[2 * 32], s[3 * 32]); o.z = cvt_pk_bf16(s[4 * 32], s[5 * 32]); o.w = cvt_pk_bf16(s[6 * 32], s[7 * 32]);
        *(v4u*)(WT + (size_t)map(n0 + n) * ldt + k0 + 8 * c) = o; }
    LDS_WAIT(); asm volatile("" ::: "memory");
}
__device__ __forceinline__ void p0_transpose_item_fp8(const float* W, int N, unsigned char* WT, int ldt, float sc, LAS float* scr, int item, int lane) {
    const int nblk = N / 32, kb = item / nblk, nb = item % nblk, k0 = 128 * kb, n0 = 32 * nb, lr = lane >> 3, lq = lane & 7;
    f32x4 v[16];
#pragma unroll
    for (int i = 0; i < 16; ++i) v[i] = __builtin_nontemporal_load((const f32x4*)(W + (size_t)(k0 + 8 * i + lr) * N + n0 + 4 * lq));
#pragma unroll
    for (int i = 0; i < 16; ++i) { const int k = 8 * i + lr; *(LAS f32x4*)(scr + k * 32 + 4 * (lq ^ ((k >> 4) & 7))) = v[i] * sc; }
    LDS_WAIT(); asm volatile("" ::: "memory");
    const int c = lq;
#pragma unroll
    for (int j = 0; j < 4; ++j) { const int n = lr + 8 * j; const LAS float* s = scr + (16 * c) * 32 + 4 * ((n >> 2) ^ c) + (n & 3);
        v4u o; o.x = pk4_fp8(s[0 * 32], s[1 * 32], s[2 * 32], s[3 * 32]); o.y = pk4_fp8(s[4 * 32], s[5 * 32], s[6 * 32], s[7 * 32]);
        o.z = pk4_fp8(s[8 * 32], s[9 * 32], s[10 * 32], s[11 * 32]); o.w = pk4_fp8(s[12 * 32], s[13 * 32], s[14 * 32], s[15 * 32]);
        __builtin_nontemporal_store(o, (v4u*)(WT + (size_t)(n0 + n) * ldt + k0 + 16 * c)); }
    LDS_WAIT(); asm volatile("" ::: "memory");
}
struct MapId { int off; __device__ int operator()(int n) const { return n + off; } };
struct MapIn { __device__ int operator()(int n) const {
    if (n < 2560) return n;
    if (n < 2592) return 3904 + (n - 2560);
    if (n < 3360) return PC_QA + (n - 2592);
    if (n < 3872) return PC_KVA + (n - 3360);
    const int j = n - 3872; return 3840 + ((j & 31) << 1) + (j >> 5); } };
struct MapQB { __device__ int operator()(int n) const { const int h = n / QKD, d = n - h * QKD; if (d < QK_NOPE) return n; const int j = d - QK_NOPE; return h * QKD + QK_NOPE + ((j & 31) << 1) + (j >> 5); } };

__device__ __forceinline__ void p0_prologue(Frame& F) {
    LAS float* scr = (LAS float*)(F.lds + F.wave * 16384);
    const int gw = F.c * NWAVES + F.wave, NGW = F.G * NWAVES, lane = F.lane;
    unsigned char* ws = F.ws;
    { const int* pos = (const int*)F.in[I_POS]; float* rope = (float*)(ws + WS_ROPE);
      for (int i = gw * 64 + lane; i < NT * 32; i += NGW * 64) { const int t = i >> 5, j = i & 31;
          const float inv = powf(10000.f, -(float)(2 * j) / 64.f); const float ang = (float)pos[t] * inv; float sn, cs; sincosf(ang, &sn, &cs); rope[2 * i] = cs; rope[2 * i + 1] = sn; } }
    { bf16* wh = (bf16*)(ws + WS_WRT); bf16* wl = wh + NEXP * DM; const float* wr = F.in[I_WR]; const float* n2 = F.in[I_NORM2];
      for (int i = gw * 64 + lane; i < NEXP * DM; i += NGW * 64) { const int e = i >> 11, k = i & (DM - 1); const float w = wr[(size_t)k * NEXP + e] * n2[k];
          const unsigned h = cvt_pk_bf16(w, 0.f) & 0xffffu; const float r = w - bf_lo(h); wh[i] = (bf16)h; wl[i] = (bf16)(cvt_pk_bf16(r, 0.f) & 0xffffu); } }
    { v4u* pad = (v4u*)(ws + WS_WIN + (size_t)IN_PROJ * DM * 2); const int n16 = (NIN_PAD - IN_PROJ) * DM * 2 / 16;
      for (int i = gw * 64 + lane; i < n16; i += NGW * 64) pad[i] = (v4u){0u, 0u, 0u, 0u}; }
    { const float* x = F.in[I_X]; const float* w = F.in[I_NORM1]; bf16* xn = (bf16*)(ws + WS_XN);
      for (int m = 2 * gw; m < NT; m += 2 * NGW) {
          const f32x4* xr = (const f32x4*)(x + (size_t)m * DM) + lane; f32x4 v[2][8]; float s0 = 0.f, s1 = 0.f;
#pragma unroll
          for (int j = 0; j < 8; ++j) { v[0][j] = __builtin_nontemporal_load(xr + 64 * j); v[1][j] = __builtin_nontemporal_load(xr + DM / 4 + 64 * j); }
#pragma unroll
          for (int j = 0; j < 8; ++j) { s0 += v[0][j][0] * v[0][j][0] + v[0][j][1] * v[0][j][1] + v[0][j][2] * v[0][j][2] + v[0][j][3] * v[0][j][3];
                                        s1 += v[1][j][0] * v[1][j][0] + v[1][j][1] * v[1][j][1] + v[1][j][2] * v[1][j][2] + v[1][j][3] * v[1][j][3]; }
          const float rs0 = rsqrtf(wave_sum(s0) * (1.f / DM) + RMS_EPS), rs1 = rsqrtf(wave_sum(s1) * (1.f / DM) + RMS_EPS);
#pragma unroll
          for (int j = 0; j < 8; ++j) { const f32x4 g = *((const f32x4*)w + lane + 64 * j);
              v2u o; o.x = cvt_pk_bf16(v[0][j][0] * rs0 * g[0], v[0][j][1] * rs0 * g[1]); o.y = cvt_pk_bf16(v[0][j][2] * rs0 * g[2], v[0][j][3] * rs0 * g[3]);
              *((v2u*)(xn + (size_t)m * DM) + lane + 64 * j) = o;
              v2u p; p.x = cvt_pk_bf16(v[1][j][0] * rs1 * g[0], v[1][j][1] * rs1 * g[1]); p.y = cvt_pk_bf16(v[1][j][2] * rs1 * g[2], v[1][j][3] * rs1 * g[3]);
              *((v2u*)(xn + (size_t)(m + 1) * DM) + lane + 64 * j) = p; } } }
    constexpr int I_IN = (DM / 64) * (IN_PROJ / 32);
    for (int it = gw; it < I_IN; it += NGW) p0_transpose_item(F.in[I_WIN], IN_PROJ, (bf16*)(ws + WS_WIN), DM, MapIn{}, (const float*)nullptr, scr, it, lane);
}
__device__ __forceinline__ void dense_weights_tail(Frame& F, int start, int stride) {
    LAS float* scr = (LAS float*)(F.lds + F.wave * 16384);
    const int lane = F.lane;
    unsigned char* ws = F.ws;
    constexpr int I_QB = (Q_LORA / 64) * (1536 / 32), I_KVB = (KV_LORA / 64) * (2048 / 32), I_OUT = (DM / 64) * (DM / 32);
    constexpr int NITEMS = I_QB + I_KVB + I_OUT;
    for (int it = start; it < NITEMS; it += stride) {
        int r = it;
        if (r < I_QB) { p0_transpose_item(F.in[I_WQB], 1536, (bf16*)(ws + WS_WQB), Q_LORA, MapQB{}, F.in[I_QANW], scr, r, lane); continue; } r -= I_QB;
        if (r < I_KVB) { p0_transpose_item(F.in[I_WKVB], 2048, (bf16*)(ws + WS_WKVB), KV_LORA, MapId{0}, F.in[I_KVANW], scr, r, lane); continue; } r -= I_KVB;
        if (r < I_OUT) { const int kb = r / (DM / 32);
            const float* ks = (kb < 16) ? F.in[I_SSMNW] : (F.in[I_ATTNW] - D_SSM);
            p0_transpose_item(F.in[I_WOUT], DM, (bf16*)(ws + WS_WOUT), DM, MapId{0}, ks, scr, r, lane); continue; } r -= I_OUT;
    }
}
constexpr int MOE_NIT = NEXP * ((DM / 128) * (4096 / 32) + (DEXP / 128) * (DM / 32));
constexpr int MOE_PRE1 = 7168, MOE_PRE2 = 4096;
__device__ __forceinline__ void moe_convert_range(Frame& F, int lo, int hi, int start, int stride) {
    LAS float* scr = (LAS float*)(F.lds + F.wave * 16384);
    const int lane = F.lane;
    unsigned char* ws = F.ws;
    constexpr int I_GU1 = (DM / 128) * (4096 / 32), I_DN1 = (DEXP / 128) * (DM / 32);
    __syncthreads();
    for (int it = lo + start; it < hi; it += stride) {
        int r = it;
        if (r < NEXP * I_GU1) { const int e = r / I_GU1, q = r % I_GU1;
            p0_transpose_item_fp8(F.in[I_WGU] + (size_t)e * DM * 4096, 4096, ws + WS_WGU + (size_t)e * 4096 * DM, DM, W8_SCALE, scr, q, lane); continue; } r -= NEXP * I_GU1;
        { const int e = r / I_DN1, q = r % I_DN1;
            p0_transpose_item_fp8(F.in[I_WDN] + (size_t)e * DEXP * DM, DM, ws + WS_WDN + (size_t)e * DM * DEXP, DEXP, W8_SCALE, scr, q, lane); }
    }
    __syncthreads();
}

template <int NTOK>
__device__ __forceinline__ void conv8(const bf16* Pcol, int s0, const float* cw, const float* cb, float (&out)[NTOK][8]) {
    float w[5][8], bias[8];
#pragma unroll
    for (int j = 0; j < 5; ++j) { const f32x4 a = *(const f32x4*)(cw + j * CONV_DIM), b = *(const f32x4*)(cw + j * CONV_DIM + 4);
        w[j][0] = a[0]; w[j][1] = a[1]; w[j][2] = a[2]; w[j][3] = a[3]; w[j][4] = b[0]; w[j][5] = b[1]; w[j][6] = b[2]; w[j][7] = b[3]; }
    { const f32x4 a = *(const f32x4*)cb, b = *(const f32x4*)(cb + 4); bias[0] = a[0]; bias[1] = a[1]; bias[2] = a[2]; bias[3] = a[3]; bias[4] = b[0]; bias[5] = b[1]; bias[6] = b[2]; bias[7] = b[3]; }
#pragma unroll
    for (int t = 0; t < NTOK; ++t)
#pragma unroll
        for (int c = 0; c < 8; ++c) out[t][c] = bias[c];
#pragma unroll
    for (int r = 0; r < NTOK + 4; ++r) {
        const int s = s0 - 2 + r, sc = s < 0 ? 0 : (s > SEQ - 1 ? SEQ - 1 : s); const float msk = (s == sc) ? 1.f : 0.f;
        const v4u raw = *(const v4u*)(Pcol + (size_t)sc * NPROJ);
        float v[8]; v[0] = bf_lo(raw.x) * msk; v[1] = bf_hi(raw.x) * msk; v[2] = bf_lo(raw.y) * msk; v[3] = bf_hi(raw.y) * msk; v[4] = bf_lo(raw.z) * msk; v[5] = bf_hi(raw.z) * msk; v[6] = bf_lo(raw.w) * msk; v[7] = bf_hi(raw.w) * msk;
#pragma unroll
        for (int j = 0; j < 5; ++j) { const int t = r - j; if (t >= 0 && t < NTOK) {
#pragma unroll
            for (int c = 0; c < 8; ++c) out[t][c] += w[j][c] * v[c]; } }
    }
#pragma unroll
    for (int t = 0; t < NTOK; ++t)
#pragma unroll
        for (int c = 0; c < 8; ++c) out[t][c] = silu_f(out[t][c]);
}
__device__ __forceinline__ float softplus_f(float x) { return x > 20.f ? x : log1pf(__expf(x)); }

__device__ __forceinline__ void ssd_local_unit(Frame& F, int unit) {
    const int half = unit & 1, g = (unit >> 1) & 1, cc = (unit >> 2) & (NCHUNK - 1), b = unit >> 7;
    const int lane = F.lane, w = F.wave, hl = w >> 1, d = w & 1, h = g * 8 + half * 4 + hl;
    const int t0 = b * SEQ + cc * CHUNK;
    unsigned char* ws = F.ws;
    const bf16* PROJ = (const bf16*)(ws + WS_PROJ) + (size_t)b * SEQ * NPROJ;
    const float* cw = F.in[I_CONVW]; const float* cb = F.in[I_CONVB];
    LAS unsigned char* XT = F.lds;
    LAS unsigned char* BT = F.lds + 65536;
    LAS float* WARR = (LAS float*)(F.lds + 98304) + w * 128;
    __syncthreads();
    { const int cg = lane & 7, ts = lane >> 3, ch = h * 64 + 8 * cg, sl = 64 * d + 8 * ts; float o[8][8];
      conv8<8>(PROJ + PC_XS + ch, cc * CHUNK + sl, cw + ch, cb + ch, o);
      bf16* xtg = (bf16*)(ws + WS_XT) + ((size_t)((b * NCHUNK + cc) * SSM_HEADS + h)) * 8192;
#pragma unroll
      for (int c = 0; c < 8; ++c) { const int p = 8 * cg + c, oc = 8 * d + ts;
          v4u pk; pk.x = cvt_pk_bf16(o[0][c], o[1][c]); pk.y = cvt_pk_bf16(o[2][c], o[3][c]); pk.z = cvt_pk_bf16(o[4][c], o[5][c]); pk.w = cvt_pk_bf16(o[6][c], o[7][c]);
          *(LAS v4u*)(XT + hl * 16384 + p * 256 + ((oc ^ (p & 15)) << 4)) = pk;
          *(v4u*)(xtg + p * 128 + sl) = pk; } }
    { const int cg = lane & 15, ts = lane >> 4, n0 = 8 * cg, sl = 16 * w + 4 * ts; float o[4][8];
      conv8<4>(PROJ + PC_B + g * 128 + n0, cc * CHUNK + sl, cw + 1024 + g * 128 + n0, cb + 1024 + g * 128 + n0, o);
#pragma unroll
      for (int c = 0; c < 8; ++c) { const int n = n0 + c, oc = sl >> 3; v2u pk; pk.x = cvt_pk_bf16(o[0][c], o[1][c]); pk.y = cvt_pk_bf16(o[2][c], o[3][c]);
          *(LAS v2u*)(BT + n * 256 + ((oc ^ (n & 15)) << 4) + (ts & 1) * 8) = pk; }
      if (half == 0) { bf16* bcg = (bf16*)(ws + WS_BC) + (size_t)(t0 + sl) * 512 + g * 128 + n0;
#pragma unroll
          for (int t = 0; t < 4; ++t) { v4u pk; pk.x = cvt_pk_bf16(o[t][0], o[t][1]); pk.y = cvt_pk_bf16(o[t][2], o[t][3]); pk.z = cvt_pk_bf16(o[t][4], o[t][5]); pk.w = cvt_pk_bf16(o[t][6], o[t][7]);
              *(v4u*)(bcg + (size_t)t * 512) = pk; } } }
    { const int cg = lane & 15, ts = lane >> 4, n0 = 8 * cg, sl = 64 * half + 8 * w + 2 * ts; float o[2][8];
      conv8<2>(PROJ + PC_C + g * 128 + n0, cc * CHUNK + sl, cw + 1280 + g * 128 + n0, cb + 1280 + g * 128 + n0, o);
      bf16* bcg = (bf16*)(ws + WS_BC) + (size_t)(t0 + sl) * 512 + 256 + g * 128 + n0;
#pragma unroll
      for (int t = 0; t < 2; ++t) { v4u pk; pk.x = cvt_pk_bf16(o[t][0], o[t][1]); pk.y = cvt_pk_bf16(o[t][2], o[t][3]); pk.z = cvt_pk_bf16(o[t][4], o[t][5]); pk.w = cvt_pk_bf16(o[t][6], o[t][7]);
          *(v4u*)(bcg + (size_t)t * 512) = pk; } }
    float total;
    { const float* DT = (const float*)(ws + WS_DT); const float bias = (d ? F.in[I_DTBB] : F.in[I_DTBF])[h]; const float A = -__expf((d ? F.in[I_ALOGB] : F.in[I_ALOGF])[h]);
      const float dt0 = softplus_f(DT[(size_t)(t0 + lane) * 32 + 16 * d + h] + bias), dt1 = softplus_f(DT[(size_t)(t0 + lane + 64) * 32 + 16 * d + h] + bias);
      const float a0 = dt0 * A, a1 = dt1 * A; float c0 = a0, c1 = a1;
#pragma unroll
      for (int o = 1; o < 64; o <<= 1) { const float u0 = __shfl_up(c0, o), u1 = __shfl_up(c1, o); if (lane >= o) { c0 += u0; c1 += u1; } }
      const float tot0 = __shfl(c0, 63); c1 += tot0; total = __shfl(c1, 63);
      const float X0 = d ? (total - c0 + a0) : c0, X1 = d ? (total - c1 + a1) : c1;
      WARR[lane] = dt0 * __expf(total - X0); WARR[lane + 64] = dt1 * __expf(total - X1);
      float* dta = (float*)(ws + WS_DTA);
      *(f32x2*)(dta + (size_t)(t0 + lane) * 64 + h * 4 + 2 * d) = (f32x2){dt0, X0};
      *(f32x2*)(dta + (size_t)(t0 + lane + 64) * 64 + h * 4 + 2 * d) = (f32x2){dt1, X1};
      if (lane == 0) ((float*)(ws + WS_CD))[((size_t)(b * NCHUNK + cc) * SSM_HEADS + h) * 2 + d] = __expf(total); }
    __syncthreads();
    { const int fr = lane & 15, fq = lane >> 4;
      bf16* st = (bf16*)(ws + WS_ST) + ((size_t)(((b * NCHUNK + cc) * SSM_HEADS + h) * 2 + d)) * 8192;
#pragma unroll 1
      for (int ih = 0; ih < 2; ++ih) {
          f32x4 acc[4][4];
#pragma unroll
          for (int i = 0; i < 4; ++i)
#pragma unroll
              for (int j = 0; j < 4; ++j) acc[i][j] = (f32x4){0.f, 0.f, 0.f, 0.f};
#pragma unroll
          for (int ks = 0; ks < 4; ++ks) { const int oc = 4 * ks + fq;
              const f32x4 w0 = *(const LAS f32x4*)(WARR + 8 * oc), w1 = *(const LAS f32x4*)(WARR + 8 * oc + 4);
              bf16x8 bfr[4];
#pragma unroll
              for (int j = 0; j < 4; ++j) { const int p = 16 * j + fr; const v4u raw = *(const LAS v4u*)(XT + hl * 16384 + p * 256 + ((oc ^ (p & 15)) << 4));
                  v4u sc; sc.x = cvt_pk_bf16(bf_lo(raw.x) * w0[0], bf_hi(raw.x) * w0[1]); sc.y = cvt_pk_bf16(bf_lo(raw.y) * w0[2], bf_hi(raw.y) * w0[3]);
                  sc.z = cvt_pk_bf16(bf_lo(raw.z) * w1[0], bf_hi(raw.z) * w1[1]); sc.w = cvt_pk_bf16(bf_lo(raw.w) * w1[2], bf_hi(raw.w) * w1[3]);
                  bfr[j] = __builtin_bit_cast(bf16x8, sc); }
#pragma unroll
              for (int i = 0; i < 4; ++i) { const int n = 16 * (4 * ih + i) + fr; const bf16x8 afr = *(const LAS bf16x8*)(BT + n * 256 + ((oc ^ (n & 15)) << 4));
#pragma unroll
                  for (int j = 0; j < 4; ++j) acc[i][j] = __builtin_amdgcn_mfma_f32_16x16x32_bf16(afr, bfr[j], acc[i][j], 0, 0, 0); }
          }
#pragma unroll
          for (int i = 0; i < 4; ++i)
#pragma unroll
              for (int j = 0; j < 4; ++j) { v2u pk; pk.x = cvt_pk_bf16(acc[i][j][0], acc[i][j][1]); pk.y = cvt_pk_bf16(acc[i][j][2], acc[i][j][3]); *(v2u*)(st + (16 * j + fr) * 128 + 16 * (4 * ih + i) + 4 * fq) = pk; }
      }
    }
}

__device__ __forceinline__ void ssd_scan_item(Frame& F, int item) {
    const int hf = item & 1, d = (item >> 1) & 1, h = (item >> 2) & 15, b = item >> 6;
    bf16* st = (bf16*)(F.ws + WS_ST); const float* cd = (const float*)(F.ws + WS_CD);
    const size_t i0 = (size_t)(b * NCHUNK * SSM_HEADS + h) * 2 + d;
    v4u* p0 = (v4u*)(st + i0 * 8192 + hf * 4096) + F.tid;
    constexpr size_t CS = (size_t)SSM_HEADS * 2 * 8192 / 8;
    float carry[8];
#pragma unroll
    for (int q = 0; q < 8; ++q) carry[q] = 0.f;
#pragma unroll 1
    for (int half = 0; half < 2; ++half) {
        v4u v[16];
#pragma unroll
        for (int j = 0; j < 16; ++j) { const int cc = d ? (NCHUNK - 1 - (16 * half + j)) : (16 * half + j); v[j] = p0[(size_t)cc * CS]; }
#pragma unroll
        for (int j = 0; j < 16; ++j) { const int cc = d ? (NCHUNK - 1 - (16 * half + j)) : (16 * half + j); const float dec = cd[i0 + (size_t)cc * SSM_HEADS * 2];
            v4u o; o.x = cvt_pk_bf16(carry[0], carry[1]); o.y = cvt_pk_bf16(carry[2], carry[3]); o.z = cvt_pk_bf16(carry[4], carry[5]); o.w = cvt_pk_bf16(carry[6], carry[7]);
            p0[(size_t)cc * CS] = o;
            carry[0] = carry[0] * dec + bf_lo(v[j].x); carry[1] = carry[1] * dec + bf_hi(v[j].x); carry[2] = carry[2] * dec + bf_lo(v[j].y); carry[3] = carry[3] * dec + bf_hi(v[j].y);
            carry[4] = carry[4] * dec + bf_lo(v[j].z); carry[5] = carry[5] * dec + bf_hi(v[j].z); carry[6] = carry[6] * dec + bf_lo(v[j].w); carry[7] = carry[7] * dec + bf_hi(v[j].w); }
    }
}

__device__ __forceinline__ void ssd_out_unit(Frame& F, int unit) {
    const int g = unit & 1, cc = (unit >> 1) & (NCHUNK - 1), b = unit >> 6;
    int lane = F.lane; asm volatile("" : "+v"(lane));
    const int w = F.wave, h = g * 8 + w, fr = lane & 15, fq = lane >> 4;
    const int t0 = b * SEQ + cc * CHUNK;
    unsigned char* ws = F.ws;
    const bf16* BC = (const bf16*)(ws + WS_BC) + (size_t)t0 * 512;
    LAS unsigned char* CB = F.lds;
    LAS f32x4* AR = (LAS f32x4*)(F.lds + 32768) + w * 128;
    LAS float* SSQ = (LAS float*)(F.lds + 49152);
    LAS unsigned char* CT = F.lds + 65536;
    __syncthreads();
    { f32x4 acc[8];
#pragma unroll
      for (int i = 0; i < 8; ++i) acc[i] = (f32x4){0.f, 0.f, 0.f, 0.f};
#pragma unroll
      for (int ks = 0; ks < 4; ++ks) { const int n0 = 32 * ks + 8 * fq;
          const bf16x8 cf = *(const bf16x8*)(BC + (size_t)(16 * w + fr) * 512 + 256 + g * 128 + n0);
          { const int l = 16 * w + fr; *(LAS bf16x8*)(CT + l * 256 + (((4 * ks + fq) ^ (l & 15)) << 4)) = cf; }
#pragma unroll
          for (int i = 0; i < 8; ++i) { const bf16x8 bfg = *(const bf16x8*)(BC + (size_t)(16 * i + fr) * 512 + g * 128 + n0);
              acc[i] = __builtin_amdgcn_mfma_f32_16x16x32_bf16(bfg, cf, acc[i], 0, 0, 0); } }
      const int l = 16 * w + fr;
#pragma unroll
      for (int i = 0; i < 8; ++i) { const int oc = 2 * i + (fq >> 1); v2u pk; pk.x = cvt_pk_bf16(acc[i][0], acc[i][1]); pk.y = cvt_pk_bf16(acc[i][2], acc[i][3]);
          *(LAS v2u*)(CB + l * 256 + ((oc ^ (l & 15)) << 4) + (fq & 1) * 8) = pk; } }
    { const f32x4* dta = (const f32x4*)(ws + WS_DTA); AR[lane] = dta[(size_t)(t0 + lane) * 16 + h]; AR[lane + 64] = dta[(size_t)(t0 + lane + 64) * 16 + h]; }
    __syncthreads();
    const float dsk = F.in[I_DSKIP][h];
    const bf16* xtg = (const bf16*)(ws + WS_XT) + ((size_t)((b * NCHUNK + cc) * SSM_HEADS + h)) * 8192;
    const bf16* Z = (const bf16*)(ws + WS_PROJ) + (size_t)t0 * NPROJ + PC_Z + h * 64;
    bf16* YC = (bf16*)(ws + WS_YCAT) + (size_t)t0 * DM + h * 64;
#pragma unroll 1
    for (int hf = 0; hf < 2; ++hf) {
        f32x4 acc[4][4];
#pragma unroll
        for (int pt = 0; pt < 4; ++pt)
#pragma unroll
            for (int lt = 0; lt < 4; ++lt) acc[pt][lt] = (f32x4){0.f, 0.f, 0.f, 0.f};
        int fro = fr; asm volatile("" : "+v"(fro));
        const bf16* pv0 = (const bf16*)(ws + WS_ST) + ((size_t)(((b * NCHUNK + cc) * SSM_HEADS + h) * 2)) * 8192 + fro * 128 + 8 * fq;
        bf16x8 pq[3][4];
#define SSD_PQ(it) do { _Pragma("unroll") for (int q = 0; q < 4; ++q) pq[(it) % 3][q] = *(const bf16x8*)(pv0 + ((it) >> 2) * 8192 + (16 * q) * 128 + 32 * ((it) & 3)); } while (0)
        bf16x8 xfn[4];
#pragma unroll
        for (int pt = 0; pt < 4; ++pt) xfn[pt] = *(const bf16x8*)(xtg + (16 * pt + fro) * 128 + 8 * fq);
#pragma unroll 1
        for (int ks = 0; ks < 4; ++ks) { const int s0 = 32 * ks + 8 * fq;
            bf16x8 xf[4];
#pragma unroll
            for (int pt = 0; pt < 4; ++pt) xf[pt] = xfn[pt];
            if (ks < 3) {
#pragma unroll
                for (int pt = 0; pt < 4; ++pt) xfn[pt] = *(const bf16x8*)(xtg + (16 * pt + fro) * 128 + s0 + 32); }
            f32x4 as[8];
#pragma unroll
            for (int e = 0; e < 8; ++e) as[e] = AR[s0 + e];
#pragma unroll
            for (int lt = 0; lt < 4; ++lt) { const int l = 16 * (4 * hf + lt) + fr; const f32x4 al = AR[l];
                const v4u raw = *(const LAS v4u*)(CB + l * 256 + (((4 * ks + fq) ^ (l & 15)) << 4));
                float cbv[8]; cbv[0] = bf_lo(raw.x); cbv[1] = bf_hi(raw.x); cbv[2] = bf_lo(raw.y); cbv[3] = bf_hi(raw.y); cbv[4] = bf_lo(raw.z); cbv[5] = bf_hi(raw.z); cbv[6] = bf_lo(raw.w); cbv[7] = bf_hi(raw.w);
                float sv[8];
                const int rel = 16 * (4 * hf + lt) - 32 * ks;
                if (rel >= 32) {
#pragma unroll
                    for (int e = 0; e < 8; ++e) sv[e] = cbv[e] * (as[e][0] * __expf(al[1] - as[e][1]));
                } else if (rel <= -16) {
#pragma unroll
                    for (int e = 0; e < 8; ++e) sv[e] = cbv[e] * (as[e][2] * __expf(al[3] - as[e][3]));
                } else {
#pragma unroll
                    for (int e = 0; e < 8; ++e) { const int s = s0 + e; const bool lo = s < l, eq = s == l;
                        const float arg = lo ? (al[1] - as[e][1]) : (al[3] - as[e][3]);
                        float wgt = (lo ? as[e][0] : as[e][2]) * __expf(arg);
                        wgt += eq ? as[e][0] : 0.f;
                        sv[e] = cbv[e] * wgt + (eq ? dsk : 0.f); }
                }
                v4u pk; pk.x = cvt_pk_bf16(sv[0], sv[1]); pk.y = cvt_pk_bf16(sv[2], sv[3]); pk.z = cvt_pk_bf16(sv[4], sv[5]); pk.w = cvt_pk_bf16(sv[6], sv[7]);
                const bf16x8 sf = __builtin_bit_cast(bf16x8, pk);
#pragma unroll
                for (int pt = 0; pt < 4; ++pt) acc[pt][lt] = __builtin_amdgcn_mfma_f32_16x16x32_bf16(xf[pt], sf, acc[pt][lt], 0, 0, 0); }
        }
        SSD_PQ(0); SSD_PQ(1);
        v2u zr[4][4];
#pragma unroll
        for (int lt = 0; lt < 4; ++lt)
#pragma unroll
            for (int pt = 0; pt < 4; ++pt) zr[lt][pt] = *(const v2u*)(Z + (size_t)(16 * (4 * hf + lt) + fro) * NPROJ + 16 * pt + 4 * fq);
        { float ef[4], eb[4];
#pragma unroll
          for (int lt = 0; lt < 4; ++lt) { const f32x4 al = AR[16 * (4 * hf + lt) + fr]; ef[lt] = __expf(al[1]); eb[lt] = __expf(al[3]); }
#pragma unroll
          for (int it = 0; it < 8; ++it) {
              if (it + 2 < 8) SSD_PQ(it + 2);
              __builtin_amdgcn_sched_barrier(0);
#pragma unroll
              for (int lt = 0; lt < 4; ++lt) { const int l = 16 * (4 * hf + lt) + fr; const float e = (it >> 2) ? eb[lt] : ef[lt];
                  const v4u raw = *(const LAS v4u*)(CT + l * 256 + (((4 * (it & 3) + fq) ^ (l & 15)) << 4));
                  v4u pk; pk.x = cvt_pk_bf16(bf_lo(raw.x) * e, bf_hi(raw.x) * e); pk.y = cvt_pk_bf16(bf_lo(raw.y) * e, bf_hi(raw.y) * e); pk.z = cvt_pk_bf16(bf_lo(raw.z) * e, bf_hi(raw.z) * e); pk.w = cvt_pk_bf16(bf_lo(raw.w) * e, bf_hi(raw.w) * e);
                  const bf16x8 cf = __builtin_bit_cast(bf16x8, pk);
#pragma unroll
                  for (int pt = 0; pt < 4; ++pt) acc[pt][lt] = __builtin_amdgcn_mfma_f32_16x16x32_bf16(pq[it % 3][pt], cf, acc[pt][lt], 0, 0, 0); }
              __builtin_amdgcn_sched_barrier(0);
          } }
#undef SSD_PQ
#pragma unroll
        for (int lt = 0; lt < 4; ++lt) { const int l = 16 * (4 * hf + lt) + fr; float s = 0.f;
#pragma unroll
            for (int pt = 0; pt < 4; ++pt) { const v2u zv = zr[lt][pt];
                f32x4 y = acc[pt][lt]; y[0] *= silu_f(bf_lo(zv.x)); y[1] *= silu_f(bf_hi(zv.x)); y[2] *= silu_f(bf_lo(zv.y)); y[3] *= silu_f(bf_hi(zv.y)); acc[pt][lt] = y;
                s += y[0] * y[0] + y[1] * y[1] + y[2] * y[2] + y[3] * y[3]; }
            s += __shfl_xor(s, 16); s += __shfl_xor(s, 32);
            if (fq == 0) SSQ[l * 8 + w] = s; }
        __syncthreads();
#pragma unroll
        for (int lt = 0; lt < 4; ++lt) { const int l = 16 * (4 * hf + lt) + fr; const f32x4 a = *(const LAS f32x4*)(SSQ + l * 8), c = *(const LAS f32x4*)(SSQ + l * 8 + 4);
            float rs = rsqrtf((a[0] + a[1] + a[2] + a[3] + c[0] + c[1] + c[2] + c[3]) * (1.f / 512.f) + RMS_EPS);
            if (DBG_NO_SSM) rs = 0.f;
#pragma unroll
            for (int pt = 0; pt < 4; ++pt) { const f32x4 y = acc[pt][lt] * rs; v2u pk; pk.x = cvt_pk_bf16(y[0], y[1]); pk.y = cvt_pk_bf16(y[2], y[3]);
                *(v2u*)(YC + (size_t)l * DM + 16 * pt + 4 * fq) = pk; } }
    }
}

__device__ __forceinline__ void att_norm_rows(Frame& F) {
    const int gw = F.c * NWAVES + F.wave, NGW = F.G * NWAVES, lane = F.lane;
    const bf16* O = (const bf16*)(F.ws + WS_O); bf16* YC = (bf16*)(F.ws + WS_YCAT);
    for (int m = gw; m < NT; m += NGW) { const v4u r = *((const v4u*)(O + (size_t)m * 1024) + lane);
        const v4u r2 = *((const v4u*)(O + (size_t)m * 1024) + lane + 64);
        float v[16]; v[0] = bf_lo(r.x); v[1] = bf_hi(r.x); v[2] = bf_lo(r.y); v[3] = bf_hi(r.y); v[4] = bf_lo(r.z); v[5] = bf_hi(r.z); v[6] = bf_lo(r.w); v[7] = bf_hi(r.w);
        v[8] = bf_lo(r2.x); v[9] = bf_hi(r2.x); v[10] = bf_lo(r2.y); v[11] = bf_hi(r2.y); v[12] = bf_lo(r2.z); v[13] = bf_hi(r2.z); v[14] = bf_lo(r2.w); v[15] = bf_hi(r2.w);
        float s = 0.f;
#pragma unroll
        for (int j = 0; j < 16; ++j) s += v[j] * v[j];
        float rs = rsqrtf(wave_sum(s) * (1.f / 1024.f) + RMS_EPS);
        if (DBG_NO_ATT) rs = 0.f;
        v4u o, o2; o.x = cvt_pk_bf16(v[0] * rs, v[1] * rs); o.y = cvt_pk_bf16(v[2] * rs, v[3] * rs); o.z = cvt_pk_bf16(v[4] * rs, v[5] * rs); o.w = cvt_pk_bf16(v[6] * rs, v[7] * rs);
        o2.x = cvt_pk_bf16(v[8] * rs, v[9] * rs); o2.y = cvt_pk_bf16(v[10] * rs, v[11] * rs); o2.z = cvt_pk_bf16(v[12] * rs, v[13] * rs); o2.w = cvt_pk_bf16(v[14] * rs, v[15] * rs);
        *((v4u*)(YC + (size_t)m * DM + D_SSM) + lane) = o; *((v4u*)(YC + (size_t)m * DM + D_SSM) + lane + 64) = o2; }
}

namespace att {
constexpr int NW = 8, QBLK = 32, KVBLK = 64;
constexpr float SCALE = 0.07216878364870322f;
constexpr float THR = 8.f;
constexpr int SHM_V = KVBLK * 128 * 2, SHM_K = KVBLK * QKD * 2;
constexpr int SHM_ATTN = 3 * SHM_V + 3 * SHM_K + NW * 64 * 4;
#define KSW(row, ch) ((row) * 384 + ((((ch)) ^ (((row) >> 1) & 7)) << 4))
#define SBAR() __builtin_amdgcn_sched_barrier(0)
__device__ __forceinline__ int crow(int r, int hi) { return (r & 3) + 8 * (r >> 2) + 4 * hi; }
__device__ __forceinline__ void partialSM(f32x16& p0, f32x16& p1, float& m_reg, float& mn, float& alpha) {
    constexpr float C = SCALE * 1.4426950408889634f;
    float pmax = p0[0];
#pragma unroll
    for (int r = 1; r < 16; ++r) pmax = fmaxf(pmax, p0[r]);
#pragma unroll
    for (int r = 0; r < 16; ++r) pmax = fmaxf(pmax, p1[r]);
    { auto rr = __builtin_amdgcn_permlane32_swap(__float_as_uint(pmax), __float_as_uint(pmax), false, false);
      pmax = fmaxf(__uint_as_float(rr[0]), __uint_as_float(rr[1])); }
    if (__builtin_expect(__all(pmax - m_reg <= THR / SCALE), 1)) { mn = m_reg; alpha = 1.f; }
    else { mn = fmaxf(m_reg, pmax); alpha = __builtin_amdgcn_exp2f((m_reg - mn) * C); m_reg = mn; }
    const float mnC = -mn * C;
#pragma unroll
    for (int r = 0; r < 16; ++r) p0[r] = fmaf(p0[r], C, mnC);
#pragma unroll
    for (int r = 0; r < 16; ++r) p1[r] = fmaf(p1[r], C, mnC);
#pragma unroll
    for (int r = 0; r < 16; ++r) p0[r] = __builtin_amdgcn_exp2f(p0[r]);
}
__device__ __forceinline__ void finishSM(f32x16& p0, f32x16& p1, float alpha, float& l_reg, bf16x8& pa0, bf16x8& pa1, bf16x8& pa2, bf16x8& pa3) {
#pragma unroll
    for (int r = 0; r < 16; ++r) p1[r] = __builtin_amdgcn_exp2f(p1[r]);
    float ps = 0;
#pragma unroll
    for (int r = 0; r < 16; ++r) ps += p0[r];
#pragma unroll
    for (int r = 0; r < 16; ++r) ps += p1[r];
    { auto rr = __builtin_amdgcn_permlane32_swap(__float_as_uint(ps), __float_as_uint(ps), false, false);
      ps = __uint_as_float(rr[0]) + __uint_as_float(rr[1]); }
    l_reg = l_reg * alpha + ps;
#define PK4(P, BASE, OUT) do { unsigned a0 = cvt_pk_bf16(P[BASE + 0], P[BASE + 1]), a1 = cvt_pk_bf16(P[BASE + 2], P[BASE + 3]);   \
    unsigned b0 = cvt_pk_bf16(P[BASE + 4], P[BASE + 5]), b1 = cvt_pk_bf16(P[BASE + 6], P[BASE + 7]);                              \
    auto r0 = __builtin_amdgcn_permlane32_swap(a0, b0, false, false); auto r1 = __builtin_amdgcn_permlane32_swap(a1, b1, false, false); \
    v4u w_ = {r0[0], r1[0], r0[1], r1[1]}; OUT = __builtin_bit_cast(bf16x8, w_); } while (0)
    PK4(p0, 0, pa0); PK4(p0, 8, pa1); PK4(p1, 0, pa2); PK4(p1, 8, pa3);
#undef PK4
}
__device__ __forceinline__ void qkt(f32x16& p0, f32x16& p1, const LAS unsigned char* Ks, const bf16x8 (&qr)[12], int r32, int hi) {
    p0 = f32x16{}; p1 = f32x16{};
#pragma unroll
    for (int d0 = 0; d0 < 12; ++d0) { const int ch = d0 * 2 + hi;
        const bf16x8 b0 = *(const LAS bf16x8*)(Ks + KSW(r32, ch));
        const bf16x8 b1 = *(const LAS bf16x8*)(Ks + 32 * 384 + KSW(r32, ch));
        p0 = __builtin_amdgcn_mfma_f32_32x32x16_bf16(b0, qr[d0], p0, 0, 0, 0);
        p1 = __builtin_amdgcn_mfma_f32_32x32x16_bf16(b1, qr[d0], p1, 0, 0, 0); }
}
__device__ __forceinline__ int v_st(int k, int c) { const int kk = (k & ~0xC) | ((k & 4) << 1) | ((k & 8) >> 1); return ((kk >> 3) * 4 + (c >> 5)) * 512 + ((kk & 7) * 32 + (c & 31)) * 2; }
__device__ __forceinline__ int v_rd_base(int lane) { return ((lane & 3) << 3) | (((lane >> 2) & 3) << 6) | (((lane >> 4) & 1) << 5) | (((lane >> 5) & 1) << 8); }
constexpr int v_rd_off(int d0, int ks, int half) { return d0 * 512 + ks * 4096 + half * 2048; }
template <int OFF> __device__ __forceinline__ s16x4 tr_read(int vb) {
    s16x4 r; asm volatile("ds_read_b64_tr_b16 %0, %1 offset:%2" : "=&v"(r) : "v"(vb), "i"(OFF) : "memory"); return r;
}
template <int D0> __device__ __forceinline__ void pv_one(f32x16& od, int vb, bf16x8 pa0, bf16x8 pa1, bf16x8 pa2, bf16x8 pa3) {
    const s16x4 l0 = tr_read<v_rd_off(D0, 0, 0)>(vb), h0 = tr_read<v_rd_off(D0, 0, 1)>(vb), l1 = tr_read<v_rd_off(D0, 1, 0)>(vb), h1 = tr_read<v_rd_off(D0, 1, 1)>(vb);
    const s16x4 l2 = tr_read<v_rd_off(D0, 2, 0)>(vb), h2 = tr_read<v_rd_off(D0, 2, 1)>(vb), l3 = tr_read<v_rd_off(D0, 3, 0)>(vb), h3 = tr_read<v_rd_off(D0, 3, 1)>(vb);
    asm volatile("s_waitcnt lgkmcnt(0)" ::: "memory"); SBAR();
#define PK(L, H) (bf16x8){L[0], L[1], L[2], L[3], H[0], H[1], H[2], H[3]}
    od = __builtin_amdgcn_mfma_f32_32x32x16_bf16(pa0, PK(l0, h0), od, 0, 0, 0);
    od = __builtin_amdgcn_mfma_f32_32x32x16_bf16(pa1, PK(l1, h1), od, 0, 0, 0);
    od = __builtin_amdgcn_mfma_f32_32x32x16_bf16(pa2, PK(l2, h2), od, 0, 0, 0);
    od = __builtin_amdgcn_mfma_f32_32x32x16_bf16(pa3, PK(l3, h3), od, 0, 0, 0);
#undef PK
}
__device__ __forceinline__ void pv_d0(f32x16* o, int vb, bf16x8 pa0, bf16x8 pa1, bf16x8 pa2, bf16x8 pa3) {
    pv_one<0>(o[0], vb, pa0, pa1, pa2, pa3); pv_one<1>(o[1], vb, pa0, pa1, pa2, pa3); pv_one<2>(o[2], vb, pa0, pa1, pa2, pa3); pv_one<3>(o[3], vb, pa0, pa1, pa2, pa3);
}
__device__ __forceinline__ void attn_unit(const bf16* __restrict__ Qb, const bf16* __restrict__ KNh, const bf16* __restrict__ KPb, const bf16* __restrict__ Vh, bf16* __restrict__ Ob, LAS unsigned char* lds) {
    int tid = threadIdx.x; asm volatile("" : "+v"(tid));
    const int wid = __builtin_amdgcn_readfirstlane(tid >> 6), lane = tid & 63, r32 = lane & 31, hi = lane >> 5;
    constexpr int NSLOT = 3;
    LAS unsigned char* V_lds = lds; LAS unsigned char* K_lds = lds + NSLOT * SHM_V;
    LAS float* wsf = (LAS float*)(lds + NSLOT * (SHM_V + SHM_K)) + wid * 64; LAS float* li_l = wsf; LAS float* al_l = wsf + 32;
    float m_reg = -1e30f, l_reg = 0; f32x16 o[4] = {}; bf16x8 qr[12];
    const bf16* Qw = Qb + (size_t)(wid * QBLK + r32) * QKD + hi * 8;
#pragma unroll
    for (int d0 = 0; d0 < 12; ++d0) qr[d0] = *(const bf16x8*)(Qw + d0 * 16);
    const char* kp[3]; unsigned kst[3]; const char* vp[2];
#pragma unroll
    for (int i = 0; i < 3; ++i) { const int P = (8 * i + wid) * 64 + lane, row = P / 24, chp = P - row * 24, ch = chp ^ ((row >> 1) & 7);
        if (ch < 16) { kp[i] = (const char*)(KNh + (size_t)row * 128 + ch * 8); kst[i] = KVBLK * 128 * 2; } else { kp[i] = (const char*)(KPb + (size_t)row * 64 + (ch - 16) * 8); kst[i] = KVBLK * 64 * 2; } }
#pragma unroll
    for (int i = 0; i < 2; ++i) { const int P = (8 * i + wid) * 64 + lane, s = P >> 5, within = P & 31, kk = (s >> 2) * 8 + (within >> 2), c = (s & 3) * 32 + (within & 3) * 8;
        const int k = (kk & ~0xC) | ((kk & 4) << 1) | ((kk & 8) >> 1);
        vp[i] = (const char*)(Vh + (size_t)k * 128 + c); }
    const int vb0 = (int)(uintptr_t)V_lds + v_rd_base(lane);
#define DMA_TILE(slot) do { _Pragma("unroll") for (int i_ = 0; i_ < 3; ++i_) { __builtin_amdgcn_global_load_lds((const unsigned*)kp[i_], (LAS unsigned*)(K_lds + (slot) * SHM_K + (8 * i_ + wid) * 1024), 16, 0, 0); kp[i_] += kst[i_]; } \
    _Pragma("unroll") for (int i_ = 0; i_ < 2; ++i_) { __builtin_amdgcn_global_load_lds((const unsigned*)vp[i_], (LAS unsigned*)(V_lds + (slot) * SHM_V + (8 * i_ + wid) * 1024), 16, 0, 0); vp[i_] += KVBLK * 128 * 2; } } while (0)
#define SWAIT() asm volatile("s_waitcnt vmcnt(0)" ::: "memory")
#define RESC(a) do { if (__any((a) < 1.f)) { if (hi == 0) al_l[r32] = (a); asm volatile("s_waitcnt lgkmcnt(0)" ::: "memory"); \
    _Pragma("unroll") for (int d = 0; d < 4; ++d) _Pragma("unroll") for (int r = 0; r < 16; ++r) o[d][r] *= al_l[crow(r, hi)]; } } while (0)
    f32x16 p0, p1; float mn, al; bf16x8 pa0, pa1, pa2, pa3; constexpr int NTL = SEQ / KVBLK;
    const int grp = wid >> 2;
    __syncthreads();
    DMA_TILE(0); DMA_TILE(1); SWAIT();
    __syncthreads();
#define STAGE_NEXT(j, s2) do { SWAIT(); if ((j) + 2 < NTL) DMA_TILE(s2); } while (0)
#define SM_PV(s0) do { partialSM(p0, p1, m_reg, mn, al); RESC(al); finishSM(p0, p1, al, l_reg, pa0, pa1, pa2, pa3); SBAR(); pv_d0(o, vb0 + (s0) * SHM_V, pa0, pa1, pa2, pa3); } while (0)
    if (grp == 0) {
        int s0 = 0, s2 = 2;
#pragma unroll 1
        for (int j = 0; j < NTL; ++j) {
            SBAR(); qkt(p0, p1, K_lds + s0 * SHM_K, qr, r32, hi);
            __syncthreads();
            STAGE_NEXT(j, s2);
            SM_PV(s0);
            __syncthreads();
            s0 = (s0 == 2) ? 0 : s0 + 1; s2 = (s2 == 2) ? 0 : s2 + 1;
        }
        __syncthreads();
    } else {
        int s0 = 0, s2 = 2;
        __syncthreads();
#pragma unroll 1
        for (int j = 0; j < NTL; ++j) {
            STAGE_NEXT(j, s2);
            SBAR(); qkt(p0, p1, K_lds + s0 * SHM_K, qr, r32, hi);
            __syncthreads();
            SM_PV(s0);
            __syncthreads();
            s0 = (s0 == 2) ? 0 : s0 + 1; s2 = (s2 == 2) ? 0 : s2 + 1;
        }
    }
#undef STAGE_NEXT
#undef SM_PV
    if (hi == 0) li_l[r32] = l_reg; asm volatile("s_waitcnt lgkmcnt(0)" ::: "memory");
    float rli[16];
#pragma unroll
    for (int r = 0; r < 16; ++r) rli[r] = __builtin_amdgcn_rcpf(li_l[crow(r, hi)]);
    bf16* Ow = Ob + (size_t)(wid * QBLK) * 1024;
#pragma unroll
    for (int r = 0; r < 16; ++r) { const int orow = crow(r, hi);
#pragma unroll
        for (int d0 = 0; d0 < 4; ++d0) Ow[(size_t)orow * 1024 + d0 * 32 + r32] = (bf16)(cvt_pk_bf16(o[d0][r] * rli[r], 0.f) & 0xffffu); }
#undef DMA_TILE
#undef SWAIT
#undef RESC
}
}

typedef int i32x4 __attribute__((ext_vector_type(4)));
__device__ __forceinline__ void moe_tables(Frame& F, bool need_bases) {
    volatile LAS int* M = (volatile LAS int*)F.MISC;
    const int* UC = (const int*)(F.ws + WS_RTS);
    LAS int* SC = (LAS int*)F.lds;
    __syncthreads();
    { const int e4 = F.tid & 7, ul = F.tid >> 3; const int c = F.c, G = F.G;
      i32x4 acc[5];
#pragma unroll
      for (int j = 0; j < 5; ++j) acc[j] = (i32x4){0, 0, 0, 0};
#pragma unroll 4
      for (int i = 0; i < 16; ++i) { const int u = ul + 64 * i; const i32x4 v = *(const i32x4*)(UC + u * 32 + 4 * e4);
          acc[0] += v;
          if (need_bases) {
#pragma unroll
              for (int j = 0; j < 4; ++j) acc[1 + j] += (u < c + j * G) ? v : (i32x4){0, 0, 0, 0}; } }
#pragma unroll
      for (int j = 0; j < 5; ++j)
#pragma unroll
          for (int r = 0; r < 4; ++r) { int x = acc[j][r]; x += __shfl_xor(x, 8); x += __shfl_xor(x, 16); x += __shfl_xor(x, 32); acc[j][r] = x; }
      if (F.lane < 8) {
#pragma unroll
          for (int j = 0; j < 5; ++j) *(LAS i32x4*)(SC + (F.wave * 5 + j) * 32 + 4 * e4) = acc[j]; } }
    __syncthreads();
    if (F.tid < 160) { const int j = F.tid >> 5, e = F.tid & 31; int s = 0;
#pragma unroll
        for (int w = 0; w < 8; ++w) s += SC[(w * 5 + j) * 32 + e];
        if (j == 0) M[16 + e] = s; else M[960 + 32 * (j - 1) + e] = s; }
    __syncthreads();
    if (F.tid == 0) { int off = 0; for (int e = 0; e < NEXP; ++e) { M[64 + e] = off; off += (M[16 + e] + 255) & ~255; } M[48] = off >> 8; }
    __syncthreads();
    const int T = M[48];
    for (int t = F.tid; t < T; t += NWAVES * 64) { int e = 0;
        for (int k = 0; k < NEXP; ++k) { const int st = M[64 + k], pd = (M[16 + k] + 255) & ~255; if (st <= t * 256 && t * 256 < st + pd) e = k; }
        M[128 + t] = e; }
    __syncthreads();
}

struct RStep { v4u h[4]; f32x4 g[2]; bf16x8 w[4]; };
template <int MODE = 0>
__device__ __forceinline__ void router_phase(Frame& F) {
    const int lane = F.lane, fr = lane & 15, fq = lane >> 4, w = F.wave;
    unsigned char* ws = F.ws;
    const bf16* H = (const bf16*)(ws + WS_H); const float* n2 = F.in[I_NORM2];
    const float* ss2p = (const float*)(ws + WS_SS2P);
    unsigned char* XN8 = ws + WS_XN;
    LAS unsigned char* stg = F.lds + w * 16384;
    LAS float* LG = (LAS float*)(F.lds + w * 16384 + 8192);
    int* tok_e = (int*)(ws + WS_TOKE); int* tok_p = (int*)(ws + WS_TOKP); float* tok_g = (float*)(ws + WS_TOKG); int* uc = (int*)(ws + WS_RTS);
    const int iters = (NT / 64 + F.G - 1) / F.G;
    for (int it = 0; it < iters; ++it) {
        const int blk = it * F.G + F.c; const bool valid = blk < NT / 64;
        const int tok0 = 64 * (valid ? blk : 0);
        float rs[4];
#pragma unroll
        for (int tf = 0; tf < 4; ++tf) { const float* pz = ss2p + (size_t)(tok0 + 16 * tf + fr) * 32 + 8 * fq; const f32x4 a = *(const f32x4*)pz, b = *(const f32x4*)(pz + 4);
            float ssum = ((a[0] + a[1]) + (a[2] + a[3])) + ((b[0] + b[1]) + (b[2] + b[3])); ssum += __shfl_xor(ssum, 16); ssum += __shfl_xor(ssum, 32);
            rs[tf] = rsqrtf(ssum * (1.f / DM) + RMS_EPS); }
        int kofs = w * 256 + 8 * fq;
        asm volatile("" : "+v"(kofs));
        const bf16* hrow = H + (size_t)(tok0 + fr) * DM + kofs;
        const bf16* wh0 = (const bf16*)(ws + WS_WRT) + (size_t)fr * DM + kofs;
        f32x4 acc[4][2];
#pragma unroll
        for (int tf = 0; tf < 4; ++tf) { acc[tf][0] = (f32x4){0.f, 0.f, 0.f, 0.f}; acc[tf][1] = (f32x4){0.f, 0.f, 0.f, 0.f}; }
        auto load = [&](RStep& b, int s) {
#pragma unroll
            for (int tf = 0; tf < 4; ++tf) b.h[tf] = *(const v4u*)(hrow + (size_t)(16 * tf) * DM + 32 * s);
            b.g[0] = *(const f32x4*)(n2 + kofs + 32 * s); b.g[1] = *(const f32x4*)(n2 + kofs + 32 * s + 4);
            b.w[0] = *(const bf16x8*)(wh0 + 32 * s); b.w[1] = *(const bf16x8*)(wh0 + 16 * DM + 32 * s); b.w[2] = *(const bf16x8*)(wh0 + NEXP * DM + 32 * s); b.w[3] = *(const bf16x8*)(wh0 + (NEXP + 16) * DM + 32 * s); };
        auto compute = [&](const RStep& b, int s) {
            const f32x4 g0 = b.g[0] * X8_SCALE, g1 = b.g[1] * X8_SCALE;
#pragma unroll
            for (int tf = 0; tf < 4; ++tf) { const v4u hx = b.h[tf]; const float r = rs[tf];
                const f32x4 ha = (f32x4){bf_lo(hx.x), bf_hi(hx.x), bf_lo(hx.y), bf_hi(hx.y)}, hb = (f32x4){bf_lo(hx.z), bf_hi(hx.z), bf_lo(hx.w), bf_hi(hx.w)};
                { v2u o; o.x = pk4_fp8(ha[0] * r * g0[0], ha[1] * r * g0[1], ha[2] * r * g0[2], ha[3] * r * g0[3]); o.y = pk4_fp8(hb[0] * r * g1[0], hb[1] * r * g1[1], hb[2] * r * g1[2], hb[3] * r * g1[3]);
                  *(LAS v2u*)(stg + (16 * tf + fr) * 256 + ((s ^ (fr & 7)) << 5) + 8 * fq) = o; }
                const bf16x8 bh = __builtin_bit_cast(bf16x8, hx);
                acc[tf][0] = __builtin_amdgcn_mfma_f32_16x16x32_bf16(b.w[0], bh, acc[tf][0], 0, 0, 0); acc[tf][1] = __builtin_amdgcn_mfma_f32_16x16x32_bf16(b.w[1], bh, acc[tf][1], 0, 0, 0);
                acc[tf][0] = __builtin_amdgcn_mfma_f32_16x16x32_bf16(b.w[2], bh, acc[tf][0], 0, 0, 0); acc[tf][1] = __builtin_amdgcn_mfma_f32_16x16x32_bf16(b.w[3], bh, acc[tf][1], 0, 0, 0); } };
        if (valid) {
            RStep A, B; load(A, 0);
#pragma unroll
            for (int s = 0; s < 8; s += 2) { load(B, s + 1); SBAR(); compute(A, s); SBAR(); if (s + 2 < 8) load(A, s + 2); SBAR(); compute(B, s + 1); SBAR(); }
            LDS_WAIT(); asm volatile("" ::: "memory");
#pragma unroll
            for (int i = 0; i < 16; ++i) { const int t = 4 * i + fq, j = fr;
                *(v4u*)(XN8 + (size_t)(tok0 + t) * DM + w * 256 + j * 16) = *(const LAS v4u*)(stg + t * 256 + (((j >> 1) ^ (t & 7)) << 5) + (j & 1) * 16); }
            LDS_WAIT(); asm volatile("" ::: "memory");
#pragma unroll
            for (int tf = 0; tf < 4; ++tf) { *(LAS f32x4*)(stg + ((16 * tf + fr) * 32 + 4 * fq) * 4) = acc[tf][0]; *(LAS f32x4*)(stg + ((16 * tf + fr) * 32 + 16 + 4 * fq) * 4) = acc[tf][1]; }
        }
        __syncthreads();
        if (valid && w < 4) {
        const int u = blk * 4 + w;
        f32x4 acc0 = (f32x4){0.f, 0.f, 0.f, 0.f}, acc1 = (f32x4){0.f, 0.f, 0.f, 0.f};
#pragma unroll
        for (int ww = 0; ww < 8; ++ww) { const LAS unsigned char* pp = F.lds + ww * 16384 + ((16 * w + fr) * 32 + 4 * fq) * 4; acc0 += *(const LAS f32x4*)pp; acc1 += *(const LAS f32x4*)(pp + 64); }
        const float rsu = (w == 0) ? rs[0] : (w == 1) ? rs[1] : (w == 2) ? rs[2] : rs[3];
        *(LAS f32x4*)(LG + fr * 32 + 4 * fq) = acc0 * rsu; *(LAS f32x4*)(LG + fr * 32 + 16 + 4 * fq) = acc1 * rsu;
        LDS_WAIT(); asm volatile("" ::: "memory");
        {
            const float* br = F.in[I_BR]; float v[32];
#pragma unroll
            for (int e = 0; e < 32; ++e) v[e] = LG[(lane & 15) * 32 + e] + br[e];
            unsigned taken = 0u; float tv[4]; int te[4];
#pragma unroll
            for (int k = 0; k < 4; ++k) { float best = -3.0e38f; int bi = 0;
#pragma unroll
                for (int e = 0; e < 32; ++e) { const bool ok = !((taken >> e) & 1u) && v[e] > best; best = ok ? v[e] : best; bi = ok ? e : bi; }
                taken |= 1u << bi; tv[k] = best; te[k] = (lane < 16) ? bi : -1; }
            int rk[4] = {0, 0, 0, 0}, myc = 0; const unsigned long long low = (1ull << lane) - 1ull;
#pragma unroll 2
            for (int e = 0; e < 32; ++e) {
                const unsigned long long b0 = __ballot(te[0] == e), b1 = __ballot(te[1] == e), b2 = __ballot(te[2] == e), b3 = __ballot(te[3] == e);
                const int lower = __popcll(b0 & low) + __popcll(b1 & low) + __popcll(b2 & low) + __popcll(b3 & low);
                const int cnt = __popcll(b0) + __popcll(b1) + __popcll(b2) + __popcll(b3);
#pragma unroll
                for (int k = 0; k < 4; ++k) rk[k] = (te[k] == e) ? lower : rk[k];
                myc = (lane == e) ? cnt : myc; }
            if (lane < 32) uc[u * 32 + lane] = myc;
            if (lane < 16) {
                const float e1 = __expf(tv[1] - tv[0]), e2 = __expf(tv[2] - tv[0]), e3 = __expf(tv[3] - tv[0]); const float inv = 1.f / (1.f + e1 + e2 + e3);
                const float gk[4] = {inv, e1 * inv, e2 * inv, e3 * inv};
                const int tk = 16 * u + lane;
#pragma unroll
                for (int k = 0; k < 4; ++k) { tok_e[tk * 4 + k] = te[k]; tok_p[tk * 4 + k] = rk[k]; tok_g[tk * 4 + k] = gk[k]; }
            }
        }
        LDS_WAIT(); asm volatile("" ::: "memory");
        }
        __syncthreads();
    }
}

__device__ __forceinline__ void gather_phase(Frame& F) {
    volatile LAS int* M = (volatile LAS int*)F.MISC;
    unsigned char* ws = F.ws; const int* tok_e = (const int*)(ws + WS_TOKE); const int* tok_p = (const int*)(ws + WS_TOKP); int* tok_r = (int*)(ws + WS_TOKR); int* rtok = (int*)(ws + WS_XG);
    if (F.c < NEXP) { const int cnt = M[16 + F.c], st = M[64 + F.c], pd = (cnt + 255) & ~255; for (int r = cnt + F.tid; r < pd; r += NWAVES * 64) rtok[st + r] = 0; }
    for (int ju = 0; ju < 4; ++ju) { const int u = F.c + ju * F.G; if (u >= NT / 16) break;
        if (F.tid < 64) { const int i = 64 * u + F.tid, e = tok_e[i], row = M[64 + e] + M[960 + 32 * ju + e] + tok_p[i];
            tok_r[i] = row; rtok[row] = i >> 2; }
    }
}

__device__ __forceinline__ void final_phase(Frame& F) {
    const int gw = F.c * NWAVES + F.wave, NGW = F.G * NWAVES, lane = F.lane;
    unsigned char* ws = F.ws; const bf16* H = (const bf16*)(ws + WS_H); const unsigned char* Y = ws + WS_Y;
    const int* tok_p = (const int*)(ws + WS_TOKR); const float* tok_g = (const float*)(ws + WS_TOKG); const float* fw = F.in[I_FNW];
    for (int t = gw; t < NT; t += NGW) {
        f32x4 v[8]; const v2u* hr = (const v2u*)(H + (size_t)t * DM) + lane;
#pragma unroll
        for (int j = 0; j < 8; ++j) { const v2u hx = hr[64 * j]; v[j] = (f32x4){bf_lo(hx.x), bf_hi(hx.x), bf_lo(hx.y), bf_hi(hx.y)}; }
#if DBG_PROBE
        { f32x4* orow_ = (f32x4*)(F.out + (size_t)t * DM) + lane;
#pragma unroll
          for (int j = 0; j < 8; ++j) { f32x4 q_;
#if DBG_PROBE_F32
              q_ = *((const f32x4*)((const float*)(ws + DBG_PROBE_OFF) + (size_t)t * DBG_PROBE_LD) + ((lane + 64 * j) % (DBG_PROBE_LD / 4)));
#else
              { const v2u r_ = *((const v2u*)((const bf16*)(ws + DBG_PROBE_OFF) + (size_t)t * DBG_PROBE_LD) + ((lane + 64 * j) % (DBG_PROBE_LD / 4))); q_[0] = bf_lo(r_.x); q_[1] = bf_hi(r_.x); q_[2] = bf_lo(r_.y); q_[3] = bf_hi(r_.y); }
#endif
              q_ = q_ * 64.f; q_[0] -= floorf(q_[0]); q_[1] -= floorf(q_[1]); q_[2] -= floorf(q_[2]); q_[3] -= floorf(q_[3]); orow_[64 * j] = q_; }
          continue; }
#endif
        if (!DBG_NO_MOE) {
#pragma unroll
            for (int k = 0; k < 4; ++k) { const int row = tok_p[t * 4 + k]; const float g = tok_g[t * 4 + k] * (1.f / Y8_SCALE); const unsigned* yr = (const unsigned*)(Y + (size_t)row * DM) + lane;
#pragma unroll
                for (int j = 0; j < 8; ++j) { const unsigned y = __builtin_nontemporal_load(yr + 64 * j);
                    const f32x2 lo = __builtin_amdgcn_cvt_pk_f32_fp8((int)y, false), hi = __builtin_amdgcn_cvt_pk_f32_fp8((int)y, true);
                    v[j][0] += g * lo[0]; v[j][1] += g * lo[1]; v[j][2] += g * hi[0]; v[j][3] += g * hi[1]; } }
        }
        float s = 0.f;
#pragma unroll
        for (int j = 0; j < 8; ++j) s += v[j][0] * v[j][0] + v[j][1] * v[j][1] + v[j][2] * v[j][2] + v[j][3] * v[j][3];
        const float rs = rsqrtf(wave_sum(s) * (1.f / DM) + RMS_EPS);
        f32x4* orow = (f32x4*)(F.out + (size_t)t * DM) + lane;
#pragma unroll
        for (int j = 0; j < 8; ++j) { const f32x4 g = *((const f32x4*)fw + lane + 64 * j); __builtin_nontemporal_store(v[j] * rs * g, orow + 64 * j); }
    }
}

struct Args { const float* in[26]; float* out; unsigned char* ws; int ph_lo, ph_hi; };
__global__ void __launch_bounds__(NWAVES * 64, 2) hymba_fwd(Args args) {
    extern __shared__ __attribute__((aligned(16))) unsigned char lds_raw[];
    Frame F;
    F.lds = (LAS unsigned char*)lds_raw;
    F.MISC = (volatile LAS unsigned*)(F.lds + MISC_OFF);
    F.tid = threadIdx.x; F.lane = F.tid & 63; F.wave = __builtin_amdgcn_readfirstlane(F.tid >> 6);
    F.G = gridDim.x; F.c = blockIdx.x;
    F.ws = args.ws; F.ctl = (gu32*)(args.ws + WS_CTL); F.out = args.out;
#pragma unroll
    for (int i = 0; i < 26; ++i) F.in[i] = args.in[i];
    for (int u = F.tid; u < (LDS_BYTES - MISC_OFF) / 4; u += NWAVES * 64) F.MISC[u] = 0u;
    __syncthreads();
    const int lo = args.ph_lo, hi = args.ph_hi;
    XcdBarrier bar; bar.bar = (unsigned*)(F.ctl + CW_BAR); bar.x = 0; bar.st = nullptr;
    if (hi - lo > 1) bar = xcd_barrier_post((unsigned*)(F.ctl + CW_BAR), F.MISC);
#ifdef ONLY_PHASE
#define IN(k) ((k) == ONLY_PHASE && lo <= (k) && (k) < hi)
#else
#define IN(k) (lo <= (k) && (k) < hi)
#endif
#define SEAM(k) do { if (IN(k) && IN((k) + 1)) xcd_barrier(bar); } while (0)
    unsigned char* ws = args.ws;
    const int G = F.G, c = F.c;

    if (IN(0)) { p0_prologue(F);
#if DBG_REP == 7
        xcd_barrier(bar); p0_prologue(F);
#endif
    }
    SEAM(0);
    if (IN(1)) {
        pg8::DenseOrder S; S.init(ws + WS_XN, DM, ws + WS_WIN, DM, NT, NIN_PAD, G, c);
        EpiInProj E{(bf16*)(ws + WS_PROJ), (bf16*)(ws + WS_KPE), (float*)(ws + WS_DT), (float*)(ws + WS_SSP), (const float*)(ws + WS_ROPE)};
        pg8::gemm_phase<false>(F.lds, pg8::Geo{DM, DM, DM}, S, E);
#if DBG_REP == 1
        xcd_barrier(bar); pg8::gemm_phase<false>(F.lds, pg8::Geo{DM, DM, DM}, S, E);
#endif
        {
          const int rem = ((NT / 256) * (NIN_PAD / 256)) % G, t0 = rem ? rem : 0;
          if (c >= t0) { const int st = (c - t0) * NWAVES + F.wave, sd = (G - t0) * NWAVES; dense_weights_tail(F, st, sd); moe_convert_range(F, 0, MOE_PRE1, st, sd); } }
#if DBG_REP == 22
        { xcd_barrier(bar); pg8::DenseOrder S2 = S; S2.tstepA = 0; S2.tstepB = 0; EpiNull E2{ws + WS_Y}; pg8::gemm_phase<false>(F.lds, pg8::Geo{DM, DM, DM}, S2, E2); }
#endif
#if DBG_REP == 21
        { xcd_barrier(bar); EpiNull E2{ws + WS_Y}; pg8::gemm_phase<false>(F.lds, pg8::Geo{DM, DM, DM}, S, E2); }
#endif
    }
    SEAM(1);
    if (IN(2)) {
#if DBG_REP == 2
        for (int u = c; u < BATCH * NCHUNK * NGRP * 2; u += G) ssd_local_unit(F, u);
        xcd_barrier(bar);
#endif
        for (int u = c; u < BATCH * NCHUNK * NGRP * 2; u += G) ssd_local_unit(F, u);
        __syncthreads();
        { pg8::DenseOrder S; S.init(ws + WS_PROJ + (size_t)PC_QA * 2, NPROJ, ws + WS_WQB, Q_LORA, NT, MLA_H * QKD, G, c);
          EpiQB E{(bf16*)(ws + WS_Q), (const float*)(ws + WS_SSP), (const float*)(ws + WS_ROPE)};
          pg8::gemm_phase<false>(F.lds, pg8::Geo{NPROJ, Q_LORA, Q_LORA}, S, E); }
        { pg8::DenseOrder S; S.init(ws + WS_PROJ + (size_t)PC_KVA * 2, NPROJ, ws + WS_WKVB, KV_LORA, NT, MLA_H * 256, G, c); S.skew = 0;
          EpiKVB E{(bf16*)(ws + WS_KN), (bf16*)(ws + WS_V), (const float*)(ws + WS_SSP)};
          pg8::gemm_phase<false>(F.lds, pg8::Geo{NPROJ, KV_LORA, KV_LORA}, S, E); }
        {
          const int rem = ((NT / 256) * (MLA_H * QKD / 256)) % G, t0 = rem ? rem : 0;
          if (c >= t0) moe_convert_range(F, MOE_PRE1, MOE_PRE1 + MOE_PRE2, (c - t0) * NWAVES + F.wave, (G - t0) * NWAVES); }
    }
    SEAM(2);
    if (IN(3)) {
        const int x = c & 7, q = c >> 3, G8 = G >> 3;
        const int team = x * 2 + ((q >> 4) & 1), grp = team % 3;
        const int nteam = 2 * 8, gteams = (nteam - grp + 2) / 3, grank = (team / 3) * 16 + (q & 15), gsize = gteams * 16;
        constexpr int NREM = MOE_NIT - MOE_PRE1 - MOE_PRE2;
        const int tb0 = (grp == 0) ? 0 : (grp == 1) ? (nteam + 2) / 3 : (nteam + 2) / 3 + (nteam + 1) / 3, tb1 = tb0 + gteams;
        const int cv_lo = MOE_PRE1 + MOE_PRE2 + (int)((long)tb0 * NREM / nteam), cv_hi = MOE_PRE1 + MOE_PRE2 + (int)((long)tb1 * NREM / nteam);
#if DBG_REP == 3
#pragma unroll 1
        for (int rep_ = 0; rep_ < 2; ++rep_) { if (rep_) xcd_barrier(bar);
#else
        { constexpr int rep_ = 0;
#endif
#pragma unroll 1
        for (int s = 0; ; ++s) {
            if (s == grp && rep_ == 0) { for (int it = c; it < BATCH * SSM_HEADS * 2 * 2; it += G) ssd_scan_item(F, it); moe_convert_range(F, cv_lo, cv_hi, grank * NWAVES + F.wave, gsize * NWAVES); }
            const int v = s * G8 + q; const int pr = v >> 4, qb = v & 15;
            if (pr >= 4) { if (s >= grp) break; else continue; }
            const int pair = pr * 8 + x, b = pair >> 3, h = pair & 7;
            const size_t bh = (size_t)(b * MLA_H + h);
            att::attn_unit((const bf16*)(ws + WS_Q) + (bh * SEQ + qb * 256) * QKD, (const bf16*)(ws + WS_KN) + bh * SEQ * 128, (const bf16*)(ws + WS_KPE) + (size_t)b * SEQ * 64,
                           (const bf16*)(ws + WS_V) + bh * SEQ * 128, (bf16*)(ws + WS_O) + ((size_t)(b * SEQ + qb * 256)) * 1024 + h * 128, F.lds);
        }
        }
    }
    SEAM(3);
    if (IN(4)) {
#if DBG_REP == 4
        for (int u = c; u < BATCH * NCHUNK * NGRP; u += G) ssd_out_unit(F, u);
        xcd_barrier(bar);
#endif
        for (int u = c; u < BATCH * NCHUNK * NGRP; u += G) ssd_out_unit(F, u);
        att_norm_rows(F);
    }
    SEAM(4);
    if (IN(5)) {
        pg8::DenseOrder S; S.init(ws + WS_YCAT, DM, ws + WS_WOUT, DM, NT, DM, G, c);
        EpiOut E{F.in[I_X], (bf16*)(ws + WS_H), (float*)(ws + WS_SS2P)};
        pg8::gemm_phase<false>(F.lds, pg8::Geo{DM, DM, DM}, S, E);
#if DBG_REP == 9 + 1
        xcd_barrier(bar); pg8::gemm_phase<false>(F.lds, pg8::Geo{DM, DM, DM}, S, E);
#endif
    }
    SEAM(5);
    if (IN(6)) { router_phase(F);
#if DBG_REP == 6
        xcd_barrier(bar); router_phase(F);
#endif
#if DBG_REP == 16
        xcd_barrier(bar); router_phase<1>(F);
#endif
#if DBG_REP == 17
        xcd_barrier(bar); router_phase<2>(F);
#endif
    }
    SEAM(6);
    if (IN(7)) { moe_tables(F, true); gather_phase(F);
#if DBG_REP == 11
        xcd_barrier(bar); moe_tables(F, true); gather_phase(F);
#endif
    }
    SEAM(7);
    if (IN(8)) {
        moe_tables(F, false);
        MoeOrder<2> S; S.init(ws + WS_XN, DM / 2, ws + WS_WGU, DM / 2, (size_t)4096 * DM, (const LAS int*)(F.lds + MISC_OFF) + 128, (int)F.MISC[48], G, c);
        S.rtok = (const int*)(ws + WS_XG);
        EpiGU E{ws + WS_ACT, F.in[I_BGU]};
        pg8::gemm_phase<true, EpiGU, MoeOrder<2>, false, true>(F.lds, pg8::Geo{DM / 2, DM / 2, DM / 2}, S, E);
#if DBG_REP == 8
        { xcd_barrier(bar); EpiGU E2{ws + WS_Y, F.in[I_BGU]}; pg8::gemm_phase<true, EpiGU, MoeOrder<2>, false, true>(F.lds, pg8::Geo{DM / 2, DM / 2, DM / 2}, S, E2); }
#endif
#if DBG_REP == 15
        { xcd_barrier(bar); EpiNull E2{ws + WS_Y}; pg8::gemm_phase<true, EpiNull, MoeOrder<2>, false, true>(F.lds, pg8::Geo{DM / 2, DM / 2, DM / 2}, S, E2); }
#endif
    }
    SEAM(8);
    if (IN(9)) {
        moe_tables(F, false);
        MoeOrder<1> S; S.init(ws + WS_ACT, DEXP / 2, ws + WS_WDN, DEXP / 2, (size_t)DM * DEXP, (const LAS int*)(F.lds + MISC_OFF) + 128, (int)F.MISC[48], G, c);
        EpiDN E{ws + WS_Y, F.in[I_BDN]};
        pg8::gemm_phase<true>(F.lds, pg8::Geo{DEXP / 2, DEXP / 2, DEXP / 2}, S, E);
#if DBG_REP == 9
        xcd_barrier(bar); pg8::gemm_phase<true>(F.lds, pg8::Geo{DEXP / 2, DEXP / 2, DEXP / 2}, S, E);
#endif
    }
    SEAM(9);
#if DBG_REP == 12
    for (int rb_ = 0; rb_ < 10; ++rb_) xcd_barrier(bar);
#endif
#if DBG_REP == 13
    if (IN(2)) { pg8::DenseOrder S; S.init(ws + WS_PROJ + (size_t)PC_QA * 2, NPROJ, ws + WS_WQB, Q_LORA, NT, MLA_H * QKD, G, c);
          EpiQB E{(bf16*)(ws + WS_Q), (const float*)(ws + WS_SSP), (const float*)(ws + WS_ROPE)};
          pg8::gemm_phase<false>(F.lds, pg8::Geo{NPROJ, Q_LORA, Q_LORA}, S, E);
          pg8::DenseOrder S2; S2.init(ws + WS_PROJ + (size_t)PC_KVA * 2, NPROJ, ws + WS_WKVB, KV_LORA, NT, MLA_H * 256, G, c);
          EpiKVB E2{(bf16*)(ws + WS_KN), (bf16*)(ws + WS_V), (const float*)(ws + WS_SSP)};
          pg8::gemm_phase<false>(F.lds, pg8::Geo{NPROJ, KV_LORA, KV_LORA}, S2, E2); xcd_barrier(bar); }
#endif
    if (IN(10)) { final_phase(F);
#if DBG_REP == 5
        xcd_barrier(bar); final_phase(F);
#endif
    }
#undef IN
#undef SEAM
}

extern "C" void kernel_launch(void* const* d_in, const int* in_sizes, int n_in, void* d_out, int out_size, void* d_ws, size_t ws_size, hipStream_t stream) {
    static int grid = 0;
    if (grid == 0) {
        if (n_in != 26 || in_sizes[0] != NT * DM || out_size != NT * DM || ws_size < WS_END) { fprintf(stderr, "kernel_launch: unexpected shapes (n_in %d, in0 %d, out %d, ws %zu < %zu)\n", n_in, n_in > 0 ? in_sizes[0] : -1, out_size, ws_size, (size_t)WS_END); grid = -1; return; }
        int dev = 0, cus = 0, per_cu = 0;
        if (hipGetDevice(&dev) != hipSuccess || hipDeviceGetAttribute(&cus, hipDeviceAttributeMultiprocessorCount, dev) != hipSuccess) { grid = -1; return; }
        if (hipFuncSetAttribute((const void*)hymba_fwd, hipFuncAttributeMaxDynamicSharedMemorySize, LDS_BYTES) != hipSuccess) { fprintf(stderr, "kernel_launch: hipFuncSetAttribute failed\n"); grid = -1; return; }
        if (hipOccupancyMaxActiveBlocksPerMultiprocessor(&per_cu, (const void*)hymba_fwd, NWAVES * 64, LDS_BYTES) != hipSuccess || per_cu < 1) { fprintf(stderr, "kernel_launch: occupancy query says %d blocks per CU\n", per_cu); }
        (void)hipGetLastError();
        grid = cus;
        if (grid % 8 != 0) { fprintf(stderr, "kernel_launch: grid %d is not a multiple of 8\n", grid); grid = -1; return; }
    }
    if (grid < 0) return;
    if (hipMemsetAsync((char*)d_ws + WS_CTL, 0, CTL_ZERO_BYTES, stream) != hipSuccess) return;
    Args a{};
    for (int i = 0; i < 26; ++i) a.in[i] = (const float*)d_in[i];
    a.out = (float*)d_out; a.ws = (unsigned char*)d_ws;
#if MK_N_LAUNCHES == 1
    a.ph_lo = 0; a.ph_hi = NPHASE;
    hipLaunchKernelGGL(hymba_fwd, dim3(grid), dim3(NWAVES * 64), LDS_BYTES, stream, a);
#else
    for (int p = 0; p < NPHASE; ++p) { a.ph_lo = p; a.ph_hi = p + 1; hipLaunchKernelGGL(hymba_fwd, dim3(grid), dim3(NWAVES * 64), LDS_BYTES, stream, a); }
#endif
    const hipError_t le = hipPeekAtLastError();
    if (le != hipSuccess) fprintf(stderr, "kernel_launch: launch failed: %s\n", hipGetErrorName(le));
}
```

```cpp
#include <hip/hip_runtime.h>
#include <cstdio>
#include <cstdint>

#ifndef MK_N_LAUNCHES
#define MK_N_LAUNCHES 1
#endif
#ifndef DBG_PROBE
#define DBG_PROBE 0
#define DBG_PROBE_F32 0
#define DBG_PROBE_OFF WS_YCAT
#define DBG_PROBE_LD 2048
#endif
#ifndef DBG_REP
#define DBG_REP 0
#endif
#ifndef DBG_REP0
#define DBG_REP0 0
#endif
#ifndef DBG_REP8
#define DBG_REP8 0
#endif
#ifndef DBG_NO_SSM
#define DBG_NO_SSM 0
#endif
#ifndef DBG_NO_ATT
#define DBG_NO_ATT 0
#endif
#ifndef DBG_NO_MOE
#define DBG_NO_MOE 0
#endif

constexpr int BATCH = 4, SEQ = 4096, NT = BATCH * SEQ, DM = 2048;
constexpr int D_SSM = 1024, SSM_HEADS = 16, HDIM = 64, NGRP = 2, DSTATE = 128, CHUNK = 128, NCHUNK = SEQ / CHUNK;
constexpr int CONV_DIM = 1536;
constexpr int MLA_H = 8, QK_NOPE = 128, QK_ROPE = 64, QKD = 192, VD = 128, Q_LORA = 768, KV_LORA = 512;
constexpr int IN_PROJ = 3936, NPROJ = 3840  , NIN_PAD = 4096;
constexpr int NEXP = 32, TOPK = 4, DEXP = 2048;
constexpr float RMS_EPS = 1e-6f;
constexpr int MAX_TILES = 288, MAX_ROWS = MAX_TILES * 256;
constexpr int NPHASE = 11;

constexpr int PC_Z = 0, PC_XS = 1024, PC_B = 2048, PC_C = 2304, PC_QA = 2560, PC_KVA = 3328;

constexpr size_t MiB = 1u << 20;
constexpr size_t WS_CTL = 0, CTL_ZERO_BYTES = 1 * MiB;
constexpr size_t WS_WIN = 1 * MiB;
constexpr size_t WS_WQB = 17 * MiB;
constexpr size_t WS_WKVB = 20 * MiB;
constexpr size_t WS_WOUT = 22 * MiB;
constexpr size_t WS_ROPE = 30 * MiB;
constexpr size_t WS_DT = 34 * MiB;
constexpr size_t WS_DTA = 36 * MiB;
constexpr size_t WS_CD = 40 * MiB;
constexpr size_t WS_KPE = 41 * MiB;
constexpr size_t WS_TOKE = 43 * MiB;
constexpr size_t WS_TOKP = WS_TOKE + 256 * 1024;
constexpr size_t WS_TOKG = WS_TOKE + 512 * 1024;
constexpr size_t WS_TOKR = WS_TOKE + 768 * 1024;
constexpr size_t WS_RTS = 44 * MiB;
constexpr size_t WS_WRT = 46 * MiB;
constexpr size_t WS_SSP = 47 * MiB;
constexpr size_t WS_SS2P = 49 * MiB;
constexpr size_t WS_XN = 64 * MiB;
constexpr size_t WS_PROJ = 128 * MiB;
constexpr size_t WS_Q = 256 * MiB;
constexpr size_t WS_KN = 304 * MiB;
constexpr size_t WS_V = 336 * MiB;
constexpr size_t WS_O = 368 * MiB;
constexpr size_t WS_XT = 432 * MiB;
constexpr size_t WS_BC = 464 * MiB;
constexpr size_t WS_ST = 480 * MiB;
constexpr size_t WS_YCAT = 608 * MiB;
constexpr size_t WS_H = 672 * MiB;
constexpr size_t WS_XG = 800 * MiB;
constexpr size_t WS_ACT = 1088 * MiB;
constexpr size_t WS_Y = 1376 * MiB;
constexpr size_t WS_WGU = 1664 * MiB;
constexpr size_t WS_WDN = 2176 * MiB;
constexpr size_t WS_END = 2432 * MiB;
constexpr int CW_BAR = 4096;
constexpr int CW_CNT = 8192;

constexpr int RING_BYTES = 131072;
constexpr int MISC_OFF = RING_BYTES;
constexpr int LDS_BYTES = 147456;
constexpr int NWAVES = 8;

#define GAS __attribute__((address_space(1)))
#define LAS __attribute__((address_space(3)))
typedef unsigned short bf16;
typedef unsigned v4u __attribute__((ext_vector_type(4)));
typedef unsigned v2u __attribute__((ext_vector_type(2)));
typedef float f32x4 __attribute__((ext_vector_type(4)));
typedef float f32x2 __attribute__((ext_vector_type(2)));
typedef float f32x16 __attribute__((ext_vector_type(16)));
typedef short bf16x8 __attribute__((ext_vector_type(8)));
typedef short s16x4 __attribute__((ext_vector_type(4)));
typedef GAS unsigned gu32;
#define RLX_AGENT __ATOMIC_RELAXED, __HIP_MEMORY_SCOPE_AGENT
#define LDS_WAIT() asm volatile("s_waitcnt lgkmcnt(0)" ::: "memory")
#define VM_WAIT() asm volatile("s_waitcnt vmcnt(0)" ::: "memory")

typedef __bf16 bfx2_t __attribute__((ext_vector_type(2)));
__device__ __forceinline__ unsigned cvt_pk_bf16(float lo, float hi) { const f32x2 v = {lo, hi}; const bfx2_t r = __builtin_convertvector(v, bfx2_t); return __builtin_bit_cast(unsigned, r); }
__device__ __forceinline__ float bf_lo(unsigned u) { return __uint_as_float(u << 16); }
__device__ __forceinline__ float bf_hi(unsigned u) { return __uint_as_float(u & 0xffff0000u); }
__device__ __forceinline__ float wave_sum(float v) {
#pragma unroll
    for (int o = 1; o < 64; o <<= 1) v += __shfl_xor(v, o);
    return v;
}
__device__ __forceinline__ float silu_f(float v) { return v * __builtin_amdgcn_rcpf(1.f + __expf(-v)); }

#define XB_TMO      128
#define XB_XCNT(j)  (256  + 64 * (j))
#define XB_XSUB(j)  (1280 + 64 * (j))
#define XB_XGEN(j)  (2304 + 64 * (j))
#define XB_TOP      3328
#define XB_TOPGEN   3392
#define XCD_BAR_WORDS 3456
#define XB_SPIN_CAP (1u << 18)

__device__ __forceinline__ unsigned xb_ld(unsigned* p)              { return __hip_atomic_load(p, __ATOMIC_RELAXED, __HIP_MEMORY_SCOPE_AGENT); }
__device__ __forceinline__ unsigned xb_add(unsigned* p, unsigned v) { return __hip_atomic_fetch_add(p, v, __ATOMIC_RELAXED, __HIP_MEMORY_SCOPE_AGENT); }
__device__ __forceinline__ unsigned xb_xcc_id() { return (unsigned)__builtin_amdgcn_s_getreg((3 << 11) | 20) & 0xFu; }
#define XB_SPIN(cond, bar) do { unsigned _sp = 0; while (cond) { __builtin_amdgcn_s_sleep(1); \
    if ((++_sp & 255u) == 0u) { if (xb_ld(&(bar)[XB_TMO])) break; if (_sp > XB_SPIN_CAP) { atomicAdd(&(bar)[XB_TMO], 1u); break; } } } } while (0)

struct XcdBarrier { unsigned* bar; unsigned x; volatile LAS unsigned* st; };

__device__ __forceinline__ XcdBarrier xcd_barrier_post(unsigned* bar, volatile LAS unsigned* st) {
    XcdBarrier b; b.bar = bar; b.x = xb_xcc_id(); b.st = st;
    if (threadIdx.x == 0) (void)xb_add(&bar[XB_XCNT(b.x)], 1u);
    return b;
}
__device__ __forceinline__ void xcd_barrier_complete(unsigned* bar, unsigned x, unsigned& nloc, unsigned& nx) {
    const unsigned G = gridDim.x * gridDim.y * gridDim.z;
    unsigned sum, cnt, mine, sp = 0u;
    for (;;) {
        sum = 0u; cnt = 0u; mine = 0u;
#pragma unroll
        for (unsigned j = 0; j < 16; ++j) { const unsigned c = xb_ld(&bar[XB_XCNT(j)]); sum += c; cnt += (c > 0u) ? 1u : 0u; mine = (j == x) ? c : mine; }
        if (sum == G) break;
        __builtin_amdgcn_s_sleep(1);
        if ((++sp & 255u) == 0u) { if (xb_ld(&bar[XB_TMO])) break; if (sp > XB_SPIN_CAP) { atomicAdd(&bar[XB_TMO], 1u); break; } }
    }
    nloc = mine > 0u ? mine : 1u; nx = cnt > 0u ? cnt : 1u;
}
__device__ __forceinline__ void xcd_barrier(const XcdBarrier& b) {
    asm volatile("s_waitcnt vmcnt(0)" ::: "memory");
    __syncthreads();
    if (threadIdx.x == 0) {
        unsigned* bar = b.bar;
        __builtin_amdgcn_s_waitcnt(0);
        unsigned nloc = b.st[0], nx = b.st[1];
        if (nloc == 0u) { xcd_barrier_complete(bar, b.x, nloc, nx); b.st[0] = nloc; b.st[1] = nx; }
        const unsigned old = xb_add(&bar[XB_XSUB(b.x)], 1u);
        const unsigned gen = old / nloc;
        if (old + 1u == (gen + 1u) * nloc) {
            __builtin_amdgcn_fence(__ATOMIC_RELEASE, "agent");
            asm volatile("s_waitcnt vmcnt(0)" ::: "memory");
            const unsigned og = xb_add(&bar[XB_TOP], 1u);
            const unsigned tg = og / nx;
            if (og + 1u == (tg + 1u) * nx) xb_add(&bar[XB_TOPGEN], 1u);
            else XB_SPIN(xb_ld(&bar[XB_TOPGEN]) == tg, bar);
            __builtin_amdgcn_fence(__ATOMIC_ACQUIRE, "agent");
            xb_add(&bar[XB_XGEN(b.x)], 1u);
            asm volatile("s_waitcnt vmcnt(0)" ::: "memory");
        } else {
            XB_SPIN(xb_ld(&bar[XB_XGEN(b.x)]) == gen, bar);
            __builtin_amdgcn_fence(__ATOMIC_ACQUIRE, "agent");
            asm volatile("s_waitcnt vmcnt(0)" ::: "memory");
        }
    }
    __syncthreads();
}

namespace pg8 {
constexpr int BM = 256, BK = 64, HALF = 128, HTB = HALF * BK * 2, STAGE_BYTES = 8 * HTB;
__device__ __forceinline__ int lds_byte(int r, int c) { const int st = (r >> 4) * 2 + (c >> 5), rr = r & 15, cc = c & 31, ob = rr * 64 + cc * 2; return st * 1024 + (ob ^ (((ob >> 9) & 1) << 5)); }
__device__ __forceinline__ void stage_rc(int b, int& R, int& C) { const int st = b / 1024, sb = b % 1024, swz = sb ^ (((sb >> 9) & 1) << 5); R = (st >> 1) * 16 + swz / 64; C = (st & 1) * 32 + (swz % 64) / 2; }
__device__ __forceinline__ int perm32(int rho) { const int n = rho >> 4, i = rho & 15; return 8 * (i >> 2) + 4 * n + (i & 3); }

typedef int v8i_t __attribute__((ext_vector_type(8)));
__device__ __forceinline__ v8i_t cat8(bf16x8 lo, bf16x8 hi) { const v4u a = __builtin_bit_cast(v4u, lo), b = __builtin_bit_cast(v4u, hi); return (v8i_t){(int)a.x, (int)a.y, (int)a.z, (int)a.w, (int)b.x, (int)b.y, (int)b.z, (int)b.w}; }
struct Unit { const char* A0; const char* B0; int pm, pn, e; };
struct Geo { int lda, ldb, K; };

template <bool FP8, class Epi, class Sched, bool BNT = false, bool GATHER = false>
__device__ __forceinline__ void gemm_phase(LAS unsigned char* lds, const Geo g, const Sched& S, const Epi& E) {
    const int tid = threadIdx.x, wid = __builtin_amdgcn_readfirstlane(tid >> 6), lane = tid & 63, wr = wid >> 2, wc = wid & 3, fr = lane & 15, fq = lane >> 4;
    const int K = g.K, nt = K / BK;
    unsigned voffA[2], voffB[2];
    unsigned voffC[2][2], voffN[2][2], cofs[2]; int rsel[2];
    constexpr bool PERM16 = FP8;
#pragma unroll
    for (int i = 0; i < 2; ++i) { int R, C; stage_rc(tid * 16 + i * 8192, R, C); const int p = perm32(R & 31);
        const int Rb = PERM16 ? (64 * (R >> 5) + p + (p & 24)) : ((R & ~31) + p);
        voffA[i] = (unsigned)(R * g.lda + C) * 2u; voffB[i] = (unsigned)(Rb * g.ldb + C) * 2u; cofs[i] = (unsigned)C * 2u; rsel[i] = R; }
    const size_t kstep = (size_t)(BK * 2);
    const size_t hstepA = (size_t)HALF * g.lda * 2, hstepB = (size_t)(PERM16 ? 8 : HALF) * g.ldb * 2;
    const unsigned ldsw = (unsigned)wid * 1024u;
    const int aoff = lds_byte(wr * 64 + fr, fq * 8), boff = lds_byte(wc * 32 + fr, fq * 8);
#define PG8_SA(b, h) (((b) * 2 + (h)) * HTB)
#define PG8_SB(b, h) ((4 + (b) * 2 + (h)) * HTB)
#define PG8_STAGE(bufoff, gbase, voff) do { _Pragma("unroll") for (int _i = 0; _i < 2; ++_i) \
        __builtin_amdgcn_global_load_lds((const unsigned*)((const char*)(gbase) + (voff)[_i]), (LAS unsigned*)(lds + (bufoff) + ldsw + _i * 8192), 16, 0, 0); } while (0)
#define PG8_STAGE_NT(bufoff, gbase, voff) do { _Pragma("unroll") for (int _i = 0; _i < 2; ++_i) \
        __builtin_amdgcn_global_load_lds((const unsigned*)((const char*)(gbase) + (voff)[_i]), (LAS unsigned*)(lds + (bufoff) + ldsw + _i * 8192), 16, 0, BNT ? 2 : 0); } while (0)
#define PG8_LD8(p) ({ const v4u lo_ = *(const LAS v4u*)(p), hi_ = *(const LAS v4u*)((p) + 1024); (v8i_t){(int)lo_.x, (int)lo_.y, (int)lo_.z, (int)lo_.w, (int)hi_.x, (int)hi_.y, (int)hi_.z, (int)hi_.w}; })
#define PG8_LDA(dst, b, h) do { if constexpr (FP8) { _Pragma("unroll") for (int m = 0; m < 4; ++m) dst##8[m] = PG8_LD8(lds + PG8_SA(b, h) + aoff + m * 2048); } \
        else { _Pragma("unroll") for (int m = 0; m < 4; ++m) _Pragma("unroll") for (int k = 0; k < 2; ++k) dst[m][k] = *(const LAS bf16x8*)(lds + PG8_SA(b, h) + aoff + m * 2048 + k * 1024); } } while (0)
#define PG8_LDB(dst, b, h) do { if constexpr (FP8) { _Pragma("unroll") for (int n = 0; n < 2; ++n) dst##8[n] = PG8_LD8(lds + PG8_SB(b, h) + boff + n * 2048); } \
        else { _Pragma("unroll") for (int n = 0; n < 2; ++n) _Pragma("unroll") for (int k = 0; k < 2; ++k) dst[n][k] = *(const LAS bf16x8*)(lds + PG8_SB(b, h) + boff + n * 2048 + k * 1024); } } while (0)
#define PG8_MMA(ai, bj, At, Bt) do { if constexpr (!FP8) __builtin_amdgcn_s_setprio(1); \
        if constexpr (FP8) { _Pragma("unroll") for (int m = 0; m < 4; ++m) _Pragma("unroll") for (int n = 0; n < 2; ++n) \
            asm volatile("v_mfma_f32_16x16x128_f8f6f4 %0, %1, %2, %0" : "+v"(acc[ai][bj][m][n]) : "v"(Bt##8[n]), "v"(At##8[m])); } \
        else { _Pragma("unroll") for (int m = 0; m < 4; ++m) _Pragma("unroll") for (int n = 0; n < 2; ++n) _Pragma("unroll") for (int k = 0; k < 2; ++k) \
            acc[ai][bj][m][n] = __builtin_amdgcn_mfma_f32_16x16x32_bf16(Bt[n][k], At[m][k], acc[ai][bj][m][n], 0, 0, 0); } \
        if constexpr (!FP8) __builtin_amdgcn_s_setprio(0); } while (0)
#define PG8_AOFF(h, nx) (GATHER ? ((nx) ? voffN[h] : voffC[h]) : voffA)
#define PG8_AH(h) (GATHER ? (size_t)0 : (size_t)(h) * hstepA)
#define PG8_WAIT_V(n) asm volatile("s_waitcnt vmcnt(" #n ")" ::: "memory")
#define PG8_WAIT_L(n) asm volatile("s_waitcnt lgkmcnt(" #n ")" ::: "memory")
#define PG8_BAR __builtin_amdgcn_s_barrier()
#define PG8_SCHED __builtin_amdgcn_sched_barrier(0)
    Unit cur, nxt; int ui = 0;
    if (!S.next(0, cur)) return;
    f32x4 acc[2][2][4][2];
#pragma unroll
    for (int a = 0; a < 2; ++a)
#pragma unroll
        for (int b = 0; b < 2; ++b)
#pragma unroll
            for (int m = 0; m < 4; ++m)
#pragma unroll
                for (int n = 0; n < 2; ++n) acc[a][b][m][n] = (f32x4){0.f, 0.f, 0.f, 0.f};
    bf16x8 At[4][2], B0[2][2], B1[2][2]; v8i_t At8[4], B08[2], B18[2];
    const char* cA = cur.A0; const char* cB = cur.B0;
    if constexpr (GATHER) { const int* rt = S.rowtab(cur);
#pragma unroll
        for (int h = 0; h < 2; ++h)
#pragma unroll
            for (int i = 0; i < 2; ++i) voffC[h][i] = (unsigned)rt[h * HALF + rsel[i]] * (unsigned)(g.lda * 2) + cofs[i]; }
    PG8_STAGE_NT(PG8_SB(0, 0), cB, voffB); PG8_STAGE(PG8_SA(0, 0), cA + PG8_AH(0), PG8_AOFF(0, false)); PG8_STAGE_NT(PG8_SB(0, 1), cB + hstepB, voffB); PG8_STAGE(PG8_SA(0, 1), cA + PG8_AH(1), PG8_AOFF(1, false));
    if (wr == 1) PG8_BAR;
    PG8_WAIT_V(4); PG8_BAR;
    PG8_STAGE_NT(PG8_SB(1, 0), cB + kstep, voffB); PG8_STAGE(PG8_SA(1, 0), cA + kstep + PG8_AH(0), PG8_AOFF(0, false)); PG8_STAGE_NT(PG8_SB(1, 1), cB + hstepB + kstep, voffB);
    PG8_WAIT_V(6); PG8_BAR;
    for (;;) {
        const bool has_next = S.next(ui + 1, nxt);
        if constexpr (GATHER) { if (has_next) { const int* rt = S.rowtab(nxt);
#pragma unroll
            for (int h = 0; h < 2; ++h)
#pragma unroll
                for (int i = 0; i < 2; ++i) asm volatile("global_load_dword %0, %1, off" : "=v"(voffN[h][i]) : "v"(rt + h * HALF + rsel[i]) : "memory"); } }
        const auto pf = E.prefetch(cur, wr, wc, fr, fq);
        const char* nA = has_next ? nxt.A0 : cA; const char* nB = has_next ? nxt.B0 : cB;
        for (int t = 0; t < nt; t += 2) {
            const bool last = (t == nt - 2);
            const char* a1 = cA + (size_t)(t + 1) * kstep;
            const char* a2 = last ? nA : cA + (size_t)(t + 2) * kstep; const char* b2 = last ? nB : cB + (size_t)(t + 2) * kstep;
            const char* a3 = a2 + kstep; const char* b3 = b2 + kstep;
            const bool nxf = last && has_next;
            if constexpr (GATHER) { if (nxf) {
#pragma unroll
                for (int h = 0; h < 2; ++h)
#pragma unroll
                    for (int i = 0; i < 2; ++i) voffN[h][i] = voffN[h][i] * (unsigned)(g.lda * 2) + cofs[i]; } }
            PG8_LDB(B0, 0, 0); PG8_SCHED; PG8_LDA(At, 0, 0); PG8_STAGE(PG8_SA(1, 1), a1 + PG8_AH(1), PG8_AOFF(1, false));
            PG8_WAIT_L(8); PG8_BAR; PG8_WAIT_L(0); PG8_MMA(0, 0, At, B0); PG8_BAR; PG8_SCHED;
            PG8_LDB(B1, 0, 1); PG8_STAGE_NT(PG8_SB(0, 0), b2, voffB);
            PG8_BAR; PG8_WAIT_L(0); PG8_MMA(0, 1, At, B1); PG8_BAR;
            PG8_LDA(At, 0, 1); PG8_STAGE(PG8_SA(0, 0), a2 + PG8_AH(0), PG8_AOFF(0, nxf));
            PG8_BAR; PG8_WAIT_L(0); PG8_MMA(1, 0, At, B0); PG8_BAR; PG8_SCHED;
            PG8_STAGE_NT(PG8_SB(0, 1), b2 + hstepB, voffB);
            PG8_WAIT_V(6); PG8_BAR; PG8_MMA(1, 1, At, B1); PG8_BAR;
            PG8_LDB(B0, 1, 0); PG8_SCHED; PG8_LDA(At, 1, 0); PG8_STAGE(PG8_SA(0, 1), a2 + PG8_AH(1), PG8_AOFF(1, nxf));
            PG8_WAIT_L(8); PG8_BAR; PG8_WAIT_L(0); PG8_MMA(0, 0, At, B0); PG8_BAR; PG8_SCHED;
            PG8_LDB(B1, 1, 1); PG8_STAGE_NT(PG8_SB(1, 0), b3, voffB);
            PG8_BAR; PG8_WAIT_L(0); PG8_MMA(0, 1, At, B1); PG8_BAR;
            PG8_LDA(At, 1, 1); PG8_STAGE(PG8_SA(1, 0), a3 + PG8_AH(0), PG8_AOFF(0, nxf));
            PG8_BAR; PG8_WAIT_L(0); PG8_MMA(1, 0, At, B0); PG8_BAR; PG8_SCHED;
            PG8_STAGE_NT(PG8_SB(1, 1), b3 + hstepB, voffB);
            PG8_WAIT_V(6); PG8_BAR; PG8_MMA(1, 1, At, B1); PG8_BAR;
        }
        if constexpr (FP8) asm volatile("s_nop 15\n\ts_nop 15" ::: "memory");
        E(acc, cur, wr, wc, fr, fq, pf);
        if (!has_next) break;
#pragma unroll
        for (int a = 0; a < 2; ++a)
#pragma unroll
            for (int b = 0; b < 2; ++b)
#pragma unroll
                for (int m = 0; m < 4; ++m)
#pragma unroll
                    for (int n = 0; n < 2; ++n) acc[a][b][m][n] = (f32x4){0.f, 0.f, 0.f, 0.f};
        cur = nxt; cA = nA; cB = nB; ++ui;
        if constexpr (GATHER) {
#pragma unroll
            for (int h = 0; h < 2; ++h)
#pragma unroll
                for (int i = 0; i < 2; ++i) voffC[h][i] = voffN[h][i]; }
    }
    PG8_WAIT_V(0);
    if (wr == 0) PG8_BAR;
    PG8_BAR;
#undef PG8_SA
#undef PG8_SB
#undef PG8_STAGE
#undef PG8_STAGE_NT
#undef PG8_LDA
#undef PG8_LDB
#undef PG8_MMA
#undef PG8_WAIT_V
#undef PG8_AOFF
#undef PG8_AH
#undef PG8_WAIT_L
#undef PG8_BAR
#undef PG8_SCHED
}

struct DenseOrder {
    const char* A; const char* Bt; size_t tstepA, tstepB; int nM, nN, nwg, G, c;
    __device__ void init(const void* A_, int lda, const void* Bt_, int ldb, int M, int N, int G_, int c_) {
        A = (const char*)A_; Bt = (const char*)Bt_; tstepA = (size_t)BM * lda * 2; tstepB = (size_t)BM * ldb * 2; nM = M / BM; nN = N / BM; nwg = nM * nN; G = G_; c = c_; }
    int skew = 0;
    __device__ bool next(int i, Unit& u) const {
        long L = (long)i * G + c;
        if (skew) { const int hG = G >> 1; if (c < hG) { if (i > 0) return false; L = c; } else { if (i > 2) return false; L = (i == 0) ? c : (c + hG * i); } }
        if (L >= nwg) return false;
        int wgid = (int)L; { const int q = nwg / 8, r = nwg % 8, xcd = wgid % 8, off = wgid / 8; wgid = (xcd < r ? xcd * (q + 1) : r * (q + 1) + (xcd - r) * q) + off; }
        const int nig = 8 * nN, gid = wgid / nig, fm = gid * 8, gsz = (nM - fm) < 8 ? (nM - fm) : 8;
        u.pm = fm + ((wgid % nig) % gsz); u.pn = (wgid % nig) / gsz; u.e = 0;
        u.A0 = A + (size_t)u.pm * tstepA; u.B0 = Bt + (size_t)u.pn * tstepB; return true;
    }
};
}

typedef const f32x4 (&AccRef)[2][2][4][2];
struct NoPf {};
struct BiasPf { f32x4 bv[2][2]; };
struct RsPf { float rs[2][4]; };
__device__ __forceinline__ v4u pack8(f32x4 v0, f32x4 v1) { v4u w; w.x = cvt_pk_bf16(v0[0], v0[1]); w.y = cvt_pk_bf16(v0[2], v0[3]); w.z = cvt_pk_bf16(v1[0], v1[1]); w.w = cvt_pk_bf16(v1[2], v1[3]); return w; }
__device__ __forceinline__ void rope4(f32x4& v0, f32x4& v1, const float* cs  ) {
    const f32x4 a = *(const f32x4*)cs, b = *(const f32x4*)(cs + 4);
    float t1, t2;
    t1 = v0[0]; t2 = v0[1]; v0[0] = t1 * a[0] - t2 * a[1]; v0[1] = t2 * a[0] + t1 * a[1];
    t1 = v0[2]; t2 = v0[3]; v0[2] = t1 * a[2] - t2 * a[3]; v0[3] = t2 * a[2] + t1 * a[3];
    t1 = v1[0]; t2 = v1[1]; v1[0] = t1 * b[0] - t2 * b[1]; v1[1] = t2 * b[0] + t1 * b[1];
    t1 = v1[2]; t2 = v1[3]; v1[2] = t1 * b[2] - t2 * b[3]; v1[3] = t2 * b[2] + t1 * b[3];
}

struct EpiInProj {
    bf16* PROJ; bf16* KPE; float* DT; float* ssp; const float* rope;
    __device__ __forceinline__ NoPf prefetch(const pg8::Unit&, int, int, int, int) const { return NoPf{}; }
    __device__ __forceinline__ void operator()(AccRef acc, const pg8::Unit& u, int wr, int wc, int fr, int fq, const NoPf&) const {
        const int row0 = u.pm * 256 + wr * 64 + fr;
        if (u.pn < 15) {
            const int col0 = u.pn * 256 + wc * 32 + 8 * fq;
            const bool wss = u.pn >= 10;
#pragma unroll
            for (int ai = 0; ai < 2; ++ai)
#pragma unroll
                for (int m = 0; m < 4; ++m) {
                    const int row = row0 + ai * 128 + m * 16; float s = 0.f;
#pragma unroll
                    for (int bj = 0; bj < 2; ++bj) {
                        const f32x4 v0 = acc[ai][bj][m][0], v1 = acc[ai][bj][m][1];
                        *(v4u*)(PROJ + (size_t)row * NPROJ + col0 + bj * 128) = pack8(v0, v1);
                        s += v0[0] * v0[0] + v0[1] * v0[1] + v0[2] * v0[2] + v0[3] * v0[3] + v1[0] * v1[0] + v1[1] * v1[1] + v1[2] * v1[2] + v1[3] * v1[3];
                    }
                    if (wss) { s += __shfl_xor(s, 16); s += __shfl_xor(s, 32); if (fq == 0) ssp[(size_t)row * 20 + (u.pn - 10) * 4 + wc] = s; }
                }
        } else {
            if (wc < 2) {
#pragma unroll
                for (int ai = 0; ai < 2; ++ai)
#pragma unroll
                    for (int m = 0; m < 4; ++m) {
                        const int row = row0 + ai * 128 + m * 16;
                        f32x4 v0 = acc[ai][0][m][0], v1 = acc[ai][0][m][1];
                        rope4(v0, v1, rope + (size_t)row * 64 + 2 * (16 * wc + 4 * fq));
                        *(v4u*)(KPE + (size_t)row * 64 + 32 * wc + 8 * fq) = pack8(v0, v1);
                    }
            } else if (wc == 2) {
#pragma unroll
                for (int ai = 0; ai < 2; ++ai)
#pragma unroll
                    for (int m = 0; m < 4; ++m) {
                        const int row = row0 + ai * 128 + m * 16;
                        *(f32x4*)(DT + (size_t)row * 32 + 8 * fq) = acc[ai][0][m][0];
                        *(f32x4*)(DT + (size_t)row * 32 + 8 * fq + 4) = acc[ai][0][m][1];
                    }
            }
        }
    }
};

struct EpiQB {
    bf16* Q; const float* ssp; const float* rope;
    __device__ __forceinline__ NoPf prefetch(const pg8::Unit&, int, int, int, int) const { return NoPf{}; }
    __device__ __forceinline__ void operator()(AccRef acc, const pg8::Unit& u, int wr, int wc, int fr, int fq, const NoPf&) const {
        const int row0 = u.pm * 256 + wr * 64 + fr;
        float rs[2][4];
        { f32x4 pv[2][4];
#pragma unroll
          for (int ai = 0; ai < 2; ++ai)
#pragma unroll
              for (int m = 0; m < 4; ++m) pv[ai][m] = *(const f32x4*)(ssp + (size_t)(row0 + ai * 128 + m * 16) * 20 + 4 * (fq < 3 ? fq : 0));
#pragma unroll
          for (int ai = 0; ai < 2; ++ai)
#pragma unroll
              for (int m = 0; m < 4; ++m) { float t = (fq < 3) ? ((pv[ai][m][0] + pv[ai][m][1]) + (pv[ai][m][2] + pv[ai][m][3])) : 0.f; t += __shfl_xor(t, 16); t += __shfl_xor(t, 32);
                  rs[ai][m] = rsqrtf(t * (1.f / Q_LORA) + RMS_EPS); } }
#pragma unroll
        for (int bj = 0; bj < 2; ++bj) {
            const int col = u.pn * 256 + bj * 128 + wc * 32 + 8 * fq, h = col / QKD, d = col - h * QKD; const bool rp = d >= QK_NOPE;
#pragma unroll
            for (int ai = 0; ai < 2; ++ai) {
                f32x4 ra[4], rb[4];
#pragma unroll
                for (int m = 0; m < 4; ++m) { const float* cs = rope + (size_t)(row0 + ai * 128 + m * 16) * 64 + (rp ? d - QK_NOPE : 0);
                    if (rp) { ra[m] = *(const f32x4*)cs; rb[m] = *(const f32x4*)(cs + 4); } else { ra[m] = (f32x4){1.f, 0.f, 1.f, 0.f}; rb[m] = (f32x4){1.f, 0.f, 1.f, 0.f}; } }
#pragma unroll
                for (int m = 0; m < 4; ++m) {
                    const int row = row0 + ai * 128 + m * 16, b = row >> 12, s = row & (SEQ - 1);
                    f32x4 v0 = acc[ai][bj][m][0] * rs[ai][m], v1 = acc[ai][bj][m][1] * rs[ai][m];
                    if (rp) { const f32x4 a = ra[m], c = rb[m]; float t1, t2;
                        t1 = v0[0]; t2 = v0[1]; v0[0] = t1 * a[0] - t2 * a[1]; v0[1] = t2 * a[0] + t1 * a[1];
                        t1 = v0[2]; t2 = v0[3]; v0[2] = t1 * a[2] - t2 * a[3]; v0[3] = t2 * a[2] + t1 * a[3];
                        t1 = v1[0]; t2 = v1[1]; v1[0] = t1 * c[0] - t2 * c[1]; v1[1] = t2 * c[0] + t1 * c[1];
                        t1 = v1[2]; t2 = v1[3]; v1[2] = t1 * c[2] - t2 * c[3]; v1[3] = t2 * c[2] + t1 * c[3]; }
                    *(v4u*)(Q + ((size_t)((b * MLA_H + h) * SEQ + s)) * QKD + d) = pack8(v0, v1);
                }
            }
        }
    }
};

struct EpiKVB {
    bf16* KN; bf16* V; const float* ssp;
    __device__ __forceinline__ NoPf prefetch(const pg8::Unit&, int, int, int, int) const { return NoPf{}; }
    __device__ __forceinline__ void operator()(AccRef acc, const pg8::Unit& u, int wr, int wc, int fr, int fq, const NoPf&) const {
        const int row0 = u.pm * 256 + wr * 64 + fr, d = wc * 32 + 8 * fq, h = u.pn;
        float rs[2][4];
        { f32x4 pv[2][4];
#pragma unroll
          for (int ai = 0; ai < 2; ++ai)
#pragma unroll
              for (int m = 0; m < 4; ++m) pv[ai][m] = *(const f32x4*)(ssp + (size_t)(row0 + ai * 128 + m * 16) * 20 + 12 + 4 * (fq >> 1));
#pragma unroll
          for (int ai = 0; ai < 2; ++ai)
#pragma unroll
              for (int m = 0; m < 4; ++m) { float t = (pv[ai][m][0] + pv[ai][m][1]) + (pv[ai][m][2] + pv[ai][m][3]); t += __shfl_xor(t, 32);
                  rs[ai][m] = rsqrtf(t * (1.f / KV_LORA) + RMS_EPS); } }
#pragma unroll
        for (int ai = 0; ai < 2; ++ai)
#pragma unroll
            for (int m = 0; m < 4; ++m) {
                const int row = row0 + ai * 128 + m * 16, b = row >> 12, s = row & (SEQ - 1); const float r = rs[ai][m];
                const size_t o = ((size_t)((b * MLA_H + h) * SEQ + s)) * 128 + d;
                *(v4u*)(KN + o) = pack8(acc[ai][0][m][0] * r, acc[ai][0][m][1] * r);
                *(v4u*)(V + o) = pack8(acc[ai][1][m][0] * r, acc[ai][1][m][1] * r);
            }
    }
};

struct EpiOut {
    const float* X; bf16* H; float* ss2p;
    __device__ __forceinline__ NoPf prefetch(const pg8::Unit&, int, int, int, int) const { return NoPf{}; }
    __device__ __forceinline__ void operator()(AccRef acc, const pg8::Unit& u, int wr, int wc, int fr, int fq, const NoPf&) const {
        const int row0 = u.pm * 256 + wr * 64 + fr, col0 = u.pn * 256 + wc * 32 + 8 * fq;
        f32x4 xb[3][4];
#define EPO_LOAD(g_) do { const float* xp_ = X + (size_t)(row0 + ((g_) >> 2) * 128 + ((g_) & 3) * 16) * DM + col0; \
        xb[(g_) % 3][0] = *(const f32x4*)xp_; xb[(g_) % 3][1] = *(const f32x4*)(xp_ + 4); xb[(g_) % 3][2] = *(const f32x4*)(xp_ + 128); xb[(g_) % 3][3] = *(const f32x4*)(xp_ + 132); } while (0)
        EPO_LOAD(0); EPO_LOAD(1);
#pragma unroll
        for (int g = 0; g < 8; ++g) { const int ai = g >> 2, m = g & 3;
            if (g + 2 < 8) EPO_LOAD(g + 2);
            const int row = row0 + ai * 128 + m * 16; float s = 0.f;
#pragma unroll
            for (int bj = 0; bj < 2; ++bj) {
                const size_t o = (size_t)row * DM + col0 + bj * 128;
                const f32x4 v0 = acc[ai][bj][m][0] + xb[g % 3][2 * bj], v1 = acc[ai][bj][m][1] + xb[g % 3][2 * bj + 1];
                *(v4u*)(H + o) = pack8(v0, v1);
                s += v0[0] * v0[0] + v0[1] * v0[1] + v0[2] * v0[2] + v0[3] * v0[3] + v1[0] * v1[0] + v1[1] * v1[1] + v1[2] * v1[2] + v1[3] * v1[3];
            }
            s += __shfl_xor(s, 16); s += __shfl_xor(s, 32); if (fq == 0) ss2p[(size_t)row * 32 + u.pn * 4 + wc] = s;
        }
#undef EPO_LOAD
    }
};

__device__ __forceinline__ float swiglu(float g, float l) {
    g = fminf(g, 7.f); l = fminf(fmaxf(l, -7.f), 7.f);
    return g * __builtin_amdgcn_rcpf(1.f + __expf(-1.702f * g)) * (l + 1.f);
}
__device__ __forceinline__ float sat8(float v) { return __builtin_amdgcn_fmed3f(v, -448.f, 448.f); }
__device__ __forceinline__ unsigned pk4_fp8(float a, float b, float c, float d) { int w = 0; w = __builtin_amdgcn_cvt_pk_fp8_f32(sat8(a), sat8(b), w, false); w = __builtin_amdgcn_cvt_pk_fp8_f32(sat8(c), sat8(d), w, true); return (unsigned)w; }
constexpr float W8_SCALE = 128.f, X8_SCALE = 16.f, A8_SCALE = 4.f;
static_assert(A8_SCALE == 4.f, "swiglu2 folds A8_SCALE = 4 into its last multiply");
__device__ __forceinline__ f32x2 swiglu2(f32x2 g, f32x2 l) {
    g = __builtin_elementwise_min(g, (f32x2){7.f, 7.f});
    l = __builtin_elementwise_min(__builtin_elementwise_max(l, (f32x2){-7.f, -7.f}), (f32x2){7.f, 7.f});
    const f32x2 t = g * (-1.702f * 1.4426950408889634f);
    f32x2 e; e[0] = __builtin_amdgcn_exp2f(t[0]); e[1] = __builtin_amdgcn_exp2f(t[1]);
    const f32x2 d = e + 1.f;
    f32x2 r; r[0] = __builtin_amdgcn_rcpf(d[0]); r[1] = __builtin_amdgcn_rcpf(d[1]);
    return (g * r) * (l * 4.f + 4.f);
}
struct EpiNull {
    unsigned char* D;
    __device__ __forceinline__ NoPf prefetch(const pg8::Unit&, int, int, int, int) const { return NoPf{}; }
    __device__ __forceinline__ void operator()(AccRef acc, const pg8::Unit& u, int wr, int wc, int fr, int fq, const NoPf&) const {
        f32x4 s = acc[0][0][0][0];
#pragma unroll
        for (int ai = 0; ai < 2; ++ai)
#pragma unroll
            for (int bj = 0; bj < 2; ++bj)
#pragma unroll
                for (int m = 0; m < 4; ++m) { s += acc[ai][bj][m][0]; s += acc[ai][bj][m][1]; }
        *(f32x4*)(D + ((size_t)(u.pm * 16 + u.pn) * 512 + threadIdx.x) * 16) = s; }
};
struct EpiGU {
    unsigned char* ACT; const float* bias;
    __device__ __forceinline__ BiasPf prefetch(const pg8::Unit& u, int wr, int wc, int fr, int fq) const { BiasPf p; const float* bp = bias + (size_t)u.e * 4096 + u.pn * 256 + wc * 64 + 16 * fq;
        asm volatile("global_load_dwordx4 %0, %4, off\n\tglobal_load_dwordx4 %1, %4, off offset:16\n\tglobal_load_dwordx4 %2, %4, off offset:32\n\tglobal_load_dwordx4 %3, %4, off offset:48"
                     : "=&v"(p.bv[0][0]), "=&v"(p.bv[0][1]), "=&v"(p.bv[1][0]), "=&v"(p.bv[1][1]) : "v"(bp) : "memory");
        return p; }
    __device__ __forceinline__ void operator()(AccRef acc, const pg8::Unit& u, int wr, int wc, int fr, int fq, const BiasPf& pfb) const {
        const int row0 = u.pm * 256 + wr * 64 + fr, col0 = u.pn * 256 + wc * 64 + 16 * fq;
        constexpr float SC = 1.f / (W8_SCALE * X8_SCALE);
        const auto& bv = pfb.bv;
#pragma unroll
        for (int ai = 0; ai < 2; ++ai)
#pragma unroll
            for (int m = 0; m < 4; ++m) {
                const int row = row0 + ai * 128 + m * 16; v2u w;
#pragma unroll
                for (int bj = 0; bj < 2; ++bj) {
                    const f32x4 v0 = acc[ai][bj][m][0] * SC + bv[bj][0], v1 = acc[ai][bj][m][1] * SC + bv[bj][1];
                    const f32x2 a = swiglu2((f32x2){v0[0], v0[2]}, (f32x2){v0[1], v0[3]}), b = swiglu2((f32x2){v1[0], v1[2]}, (f32x2){v1[1], v1[3]});
                    const unsigned q = pk4_fp8(a[0], a[1], b[0], b[1]); if (bj == 0) w.x = q; else w.y = q; }
                *(v2u*)(ACT + (size_t)row * DEXP + (col0 >> 1)) = w;
            }
    }
};
constexpr float Y8_SCALE = 16.f;
struct EpiDN {
    unsigned char* Y; const float* bias;
    __device__ __forceinline__ BiasPf prefetch(const pg8::Unit& u, int wr, int wc, int fr, int fq) const { BiasPf p; const float* bp = bias + (size_t)u.e * DM + u.pn * 256 + wc * 64 + 16 * fq;
        asm volatile("global_load_dwordx4 %0, %4, off\n\tglobal_load_dwordx4 %1, %4, off offset:16\n\tglobal_load_dwordx4 %2, %4, off offset:32\n\tglobal_load_dwordx4 %3, %4, off offset:48"
                     : "=&v"(p.bv[0][0]), "=&v"(p.bv[0][1]), "=&v"(p.bv[1][0]), "=&v"(p.bv[1][1]) : "v"(bp) : "memory");
        return p; }
    __device__ __forceinline__ void operator()(AccRef acc, const pg8::Unit& u, int wr, int wc, int fr, int fq, const BiasPf& pfb) const {
        const int row0 = u.pm * 256 + wr * 64 + fr, col0 = u.pn * 256 + wc * 64 + 16 * fq;
        const auto& bv = pfb.bv;
#pragma unroll
        for (int ai = 0; ai < 2; ++ai)
#pragma unroll
            for (int m = 0; m < 4; ++m) {
                const int row = row0 + ai * 128 + m * 16; v4u w;
#pragma unroll
                for (int bj = 0; bj < 2; ++bj) {
                    const f32x4 y0 = (acc[ai][bj][m][0] * (1.f / (W8_SCALE * A8_SCALE)) + bv[bj][0]) * Y8_SCALE, y1 = (acc[ai][bj][m][1] * (1.f / (W8_SCALE * A8_SCALE)) + bv[bj][1]) * Y8_SCALE;
                    const unsigned q0 = pk4_fp8(y0[0], y0[1], y0[2], y0[3]), q1 = pk4_fp8(y1[0], y1[1], y1[2], y1[3]);
                    if (bj == 0) { w.x = q0; w.y = q1; } else { w.z = q0; w.w = q1; } }
                *(v4u*)(Y + (size_t)row * DM + col0) = w;
            }
    }
};

template <int NPX>
struct MoeOrder {
    const char* A; const char* W; const LAS int* tile_e; size_t tstepA, tstepB, estep; int T, G8, x, q; const int* rtok = nullptr;
    __device__ void init(const void* A_, int lda, const void* W_, int ldb, size_t estep_bytes, const LAS int* te, int T_, int G, int c) {
        A = (const char*)A_; W = (const char*)W_; tile_e = te; tstepA = (size_t)256 * lda * 2; tstepB = (size_t)256 * ldb * 2; estep = estep_bytes; T = T_; G8 = G >> 3; x = c & 7; q = c >> 3; }
    __device__ bool next(int i, pg8::Unit& u) const {
        const int v = i * G8 + q, t = v / NPX, n = NPX * x + (v % NPX);
        if (t >= T) return false;
        const int e = __builtin_amdgcn_readfirstlane(tile_e[t]);
        u.pm = t; u.pn = n; u.e = e; u.A0 = rtok ? A : A + (size_t)t * tstepA; u.B0 = W + (size_t)e * estep + (size_t)n * tstepB; return true;
    }
    __device__ const int* rowtab(const pg8::Unit& u) const { return rtok + u.pm * 256; }
};

struct Frame {
    LAS unsigned char* lds;
    volatile LAS unsigned* MISC;
    gu32* ctl;
    int tid, lane, wave, G, c;
    unsigned char* ws;
    const float* in[26];
    float* out;
};
enum { I_X = 0, I_POS, I_NORM1, I_WIN, I_CONVW, I_CONVB, I_DTBF, I_DTBB, I_ALOGF, I_ALOGB, I_DSKIP, I_SSMNW, I_QANW, I_WQB, I_KVANW, I_WKVB, I_ATTNW, I_WOUT,
       I_NORM2, I_WR, I_BR, I_WGU, I_BGU, I_WDN, I_BDN, I_FNW };

template <class Map>
__device__ __forceinline__ void p0_transpose_item(const float* W, int N, bf16* WT, int ldt, const Map& map, const float* ks, LAS float* scr, int item, int lane) {
    const int nblk = N / 32, kb = item / nblk, nb = item % nblk, k0 = 64 * kb, n0 = 32 * nb, lr = lane >> 3, lq = lane & 7;
    f32x4 v[8];
#pragma unroll
    for (int i = 0; i < 8; ++i) v[i] = *(const f32x4*)(W + (size_t)(k0 + 8 * i + lr) * N + n0 + 4 * lq);
#pragma unroll
    for (int i = 0; i < 8; ++i) { const int k = 8 * i + lr; const float sc = ks ? ks[k0 + k] : 1.f; *(LAS f32x4*)(scr + k * 32 + 4 * (lq ^ ((k >> 3) & 7))) = v[i] * sc; }
    LDS_WAIT(); asm volatile("" ::: "memory");
    const int c = lq;
#pragma unroll
    for (int j = 0; j < 4; ++j) { const int n = lr + 8 * j; const LAS float* s = scr + (8 * c) * 32 + 4 * ((n >> 2) ^ c) + (n & 3);
        v4u o; o.x = cvt_pk_bf16(s[0 * 32], s[1 * 32]); o.y = cvt_pk_bf16(s[2 * 32], s[3 * 32]); o.z = cvt_pk_bf16(s[4 * 32], s[5 * 32]); o.w = cvt_pk_bf16(s[6 * 32], s[7 * 32]);
        *(v4u*)(WT + (size_t)map(n0 + n) * ldt + k0 + 8 * c) = o; }
    LDS_WAIT(); asm volatile("" ::: "memory");
}
__device__ __forceinline__ void p0_transpose_item_fp8(const float* W, int N, unsigned char* WT, int ldt, float sc, LAS float* scr, int item, int lane) {
    const int nblk = N / 32, kb = item / nblk, nb = item % nblk, k0 = 128 * kb, n0 = 32 * nb, lr = lane >> 3, lq = lane & 7;
    f32x4 v[16];
#pragma unroll
    for (int i = 0; i < 16; ++i) v[i] = __builtin_nontemporal_load((const f32x4*)(W + (size_t)(k0 + 8 * i + lr) * N + n0 + 4 * lq));
#pragma unroll
    for (int i = 0; i < 16; ++i) { const int k = 8 * i + lr; *(LAS f32x4*)(scr + k * 32 + 4 * (lq ^ ((k >> 4) & 7))) = v[i] * sc; }
    LDS_WAIT(); asm volatile("" ::: "memory");
    const int c = lq;
#pragma unroll
    for (int j = 0; j < 4; ++j) { const int n = lr + 8 * j; const LAS float* s = scr + (16 * c) * 32 + 4 * ((n >> 2) ^ c) + (n & 3);
        v4u o; o.x = pk4_fp8(s[0 * 32], s[1 * 32], s[2 * 32], s[3 * 32]); o.y = pk4_fp8(s[4 * 32], s[5 * 32], s[6 * 32], s[7 * 32]);
        o.z = pk4_fp8(s[8 * 32], s[9 * 32], s[10 * 32], s[11 * 32]); o.w = pk4_fp8(s[12 * 32], s[13 * 32], s[14 * 32], s[15 * 32]);
        __builtin_nontemporal_store(o, (v4u*)(WT + (size_t)(n0 + n) * ldt + k0 + 16 * c)); }
    LDS_WAIT(); asm volatile("" ::: "memory");
}
struct MapId { int off; __device__ int operator()(int n) const { return n + off; } };
struct MapIn { __device__ int operator()(int n) const {
    if (n < 2560) return n;
    if (n < 2592) return 3904 + (n - 2560);
    if (n < 3360) return PC_QA + (n - 2592);
    if (n < 3872) return PC_KVA + (n - 3360);
    const int j = n - 3872; return 3840 + ((j & 31) << 1) + (j >> 5); } };
struct MapQB { __device__ int operator()(int n) const { const int h = n / QKD, d = n - h * QKD; if (d < QK_NOPE) return n; const int j = d - QK_NOPE; return h * QKD + QK_NOPE + ((j & 31) << 1) + (j >> 5); } };

__device__ __forceinline__ void p0_prologue(Frame& F) {
    LAS float* scr = (LAS float*)(F.lds + F.wave * 16384);
    const int gw = F.c * NWAVES + F.wave, NGW = F.G * NWAVES, lane = F.lane;
    unsigned char* ws = F.ws;
    { const int* pos = (const int*)F.in[I_POS]; float* rope = (float*)(ws + WS_ROPE);
      for (int i = gw * 64 + lane; i < NT * 32; i += NGW * 64) { const int t = i >> 5, j = i & 31;
          const float inv = powf(10000.f, -(float)(2 * j) / 64.f); const float ang = (float)pos[t] * inv; float sn, cs; sincosf(ang, &sn, &cs); rope[2 * i] = cs; rope[2 * i + 1] = sn; } }
    { bf16* wh = (bf16*)(ws + WS_WRT); bf16* wl = wh + NEXP * DM; const float* wr = F.in[I_WR]; const float* n2 = F.in[I_NORM2];
      for (int i = gw * 64 + lane; i < NEXP * DM; i += NGW * 64) { const int e = i >> 11, k = i & (DM - 1); const float w = wr[(size_t)k * NEXP + e] * n2[k];
          const unsigned h = cvt_pk_bf16(w, 0.f) & 0xffffu; const float r = w - bf_lo(h); wh[i] = (bf16)h; wl[i] = (bf16)(cvt_pk_bf16(r, 0.f) & 0xffffu); } }
    { v4u* pad = (v4u*)(ws + WS_WIN + (size_t)IN_PROJ * DM * 2); const int n16 = (NIN_PAD - IN_PROJ) * DM * 2 / 16;
      for (int i = gw * 64 + lane; i < n16; i += NGW * 64) pad[i] = (v4u){0u, 0u, 0u, 0u}; }
    { const float* x = F.in[I_X]; const float* w = F.in[I_NORM1]; bf16* xn = (bf16*)(ws + WS_XN);
      for (int m = 2 * gw; m < NT; m += 2 * NGW) {
          const f32x4* xr = (const f32x4*)(x + (size_t)m * DM) + lane; f32x4 v[2][8]; float s0 = 0.f, s1 = 0.f;
#pragma unroll
          for (int j = 0; j < 8; ++j) { v[0][j] = __builtin_nontemporal_load(xr + 64 * j); v[1][j] = __builtin_nontemporal_load(xr + DM / 4 + 64 * j); }
#pragma unroll
          for (int j = 0; j < 8; ++j) { s0 += v[0][j][0] * v[0][j][0] + v[0][j][1] * v[0][j][1] + v[0][j][2] * v[0][j][2] + v[0][j][3] * v[0][j][3];
                                        s1 += v[1][j][0] * v[1][j][0] + v[1][j][1] * v[1][j][1] + v[1][j][2] * v[1][j][2] + v[1][j][3] * v[1][j][3]; }
          const float rs0 = rsqrtf(wave_sum(s0) * (1.f / DM) + RMS_EPS), rs1 = rsqrtf(wave_sum(s1) * (1.f / DM) + RMS_EPS);
#pragma unroll
          for (int j = 0; j < 8; ++j) { const f32x4 g = *((const f32x4*)w + lane + 64 * j);
              v2u o; o.x = cvt_pk_bf16(v[0][j][0] * rs0 * g[0], v[0][j][1] * rs0 * g[1]); o.y = cvt_pk_bf16(v[0][j][2] * rs0 * g[2], v[0][j][3] * rs0 * g[3]);
              *((v2u*)(xn + (size_t)m * DM) + lane + 64 * j) = o;
              v2u p; p.x = cvt_pk_bf16(v[1][j][0] * rs1 * g[0], v[1][j][1] * rs1 * g[1]); p.y = cvt_pk_bf16(v[1][j][2] * rs1 * g[2], v[1][j][3] * rs1 * g[3]);
              *((v2u*)(xn + (size_t)(m + 1) * DM) + lane + 64 * j) = p; } } }
    constexpr int I_IN = (DM / 64) * (IN_PROJ / 32);
    for (int it = gw; it < I_IN; it += NGW) p0_transpose_item(F.in[I_WIN], IN_PROJ, (bf16*)(ws + WS_WIN), DM, MapIn{}, (const float*)nullptr, scr, it, lane);
}
__device__ __forceinline__ void dense_weights_tail(Frame& F, int start, int stride) {
    LAS float* scr = (LAS float*)(F.lds + F.wave * 16384);
    const int lane = F.lane;
    unsigned char* ws = F.ws;
    constexpr int I_QB = (Q_LORA / 64) * (1536 / 32), I_KVB = (KV_LORA / 64) * (2048 / 32), I_OUT = (DM / 64) * (DM / 32);
    constexpr int NITEMS = I_QB + I_KVB + I_OUT;
    for (int it = start; it < NITEMS; it += stride) {
        int r = it;
        if (r < I_QB) { p0_transpose_item(F.in[I_WQB], 1536, (bf16*)(ws + WS_WQB), Q_LORA, MapQB{}, F.in[I_QANW], scr, r, lane); continue; } r -= I_QB;
        if (r < I_KVB) { p0_transpose_item(F.in[I_WKVB], 2048, (bf16*)(ws + WS_WKVB), KV_LORA, MapId{0}, F.in[I_KVANW], scr, r, lane); continue; } r -= I_KVB;
        if (r < I_OUT) { const int kb = r / (DM / 32);
            const float* ks = (kb < 16) ? F.in[I_SSMNW] : (F.in[I_ATTNW] - D_SSM);
            p0_transpose_item(F.in[I_WOUT], DM, (bf16*)(ws + WS_WOUT), DM, MapId{0}, ks, scr, r, lane); continue; } r -= I_OUT;
    }
}
constexpr int MOE_NIT = NEXP * ((DM / 128) * (4096 / 32) + (DEXP / 128) * (DM / 32));
constexpr int MOE_PRE1 = 7168, MOE_PRE2 = 4096;
__device__ __forceinline__ void moe_convert_range(Frame& F, int lo, int hi, int start, int stride) {
    LAS float* scr = (LAS float*)(F.lds + F.wave * 16384);
    const int lane = F.lane;
    unsigned char* ws = F.ws;
    constexpr int I_GU1 = (DM / 128) * (4096 / 32), I_DN1 = (DEXP / 128) * (DM / 32);
    __syncthreads();
    for (int it = lo + start; it < hi; it += stride) {
        int r = it;
        if (r < NEXP * I_GU1) { const int e = r / I_GU1, q = r % I_GU1;
            p0_transpose_item_fp8(F.in[I_WGU] + (size_t)e * DM * 4096, 4096, ws + WS_WGU + (size_t)e * 4096 * DM, DM, W8_SCALE, scr, q, lane); continue; } r -= NEXP * I_GU1;
        { const int e = r / I_DN1, q = r % I_DN1;
            p0_transpose_item_fp8(F.in[I_WDN] + (size_t)e * DEXP * DM, DM, ws + WS_WDN + (size_t)e * DM * DEXP, DEXP, W8_SCALE, scr, q, lane); }
    }
    __syncthreads();
}

template <int NTOK>
__device__ __forceinline__ void conv8(const bf16* Pcol, int s0, const float* cw, const float* cb, float (&out)[NTOK][8]) {
    float w[5][8], bias[8];
#pragma unroll
    for (int j = 0; j < 5; ++j) { const f32x4 a = *(const f32x4*)(cw + j * CONV_DIM), b = *(const f32x4*)(cw + j * CONV_DIM + 4);
        w[j][0] = a[0]; w[j][1] = a[1]; w[j][2] = a[2]; w[j][3] = a[3]; w[j][4] = b[0]; w[j][5] = b[1]; w[j][6] = b[2]; w[j][7] = b[3]; }
    { const f32x4 a = *(const f32x4*)cb, b = *(const f32x4*)(cb + 4); bias[0] = a[0]; bias[1] = a[1]; bias[2] = a[2]; bias[3] = a[3]; bias[4] = b[0]; bias[5] = b[1]; bias[6] = b[2]; bias[7] = b[3]; }
#pragma unroll
    for (int t = 0; t < NTOK; ++t)
#pragma unroll
        for (int c = 0; c < 8; ++c) out[t][c] = bias[c];
#pragma unroll
    for (int r = 0; r < NTOK + 4; ++r) {
        const int s = s0 - 2 + r, sc = s < 0 ? 0 : (s > SEQ - 1 ? SEQ - 1 : s); const float msk = (s == sc) ? 1.f : 0.f;
        const v4u raw = *(const v4u*)(Pcol + (size_t)sc * NPROJ);
        float v[8]; v[0] = bf_lo(raw.x) * msk; v[1] = bf_hi(raw.x) * msk; v[2] = bf_lo(raw.y) * msk; v[3] = bf_hi(raw.y) * msk; v[4] = bf_lo(raw.z) * msk; v[5] = bf_hi(raw.z) * msk; v[6] = bf_lo(raw.w) * msk; v[7] = bf_hi(raw.w) * msk;
#pragma unroll
        for (int j = 0; j < 5; ++j) { const int t = r - j; if (t >= 0 && t < NTOK) {
#pragma unroll
            for (int c = 0; c < 8; ++c) out[t][c] += w[j][c] * v[c]; } }
    }
#pragma unroll
    for (int t = 0; t < NTOK; ++t)
#pragma unroll
        for (int c = 0; c < 8; ++c) out[t][c] = silu_f(out[t][c]);
}
__device__ __forceinline__ float softplus_f(float x) { return x > 20.f ? x : log1pf(__expf(x)); }

__device__ __forceinline__ void ssd_local_unit(Frame& F, int unit) {
    const int half = unit & 1, g = (unit >> 1) & 1, cc = (unit >> 2) & (NCHUNK - 1), b = unit >> 7;
    const int lane = F.lane, w = F.wave, hl = w >> 1, d = w & 1, h = g * 8 + half * 4 + hl;
    const int t0 = b * SEQ + cc * CHUNK;
    unsigned char* ws = F.ws;
    const bf16* PROJ = (const bf16*)(ws + WS_PROJ) + (size_t)b * SEQ * NPROJ;
    const float* cw = F.in[I_CONVW]; const float* cb = F.in[I_CONVB];
    LAS unsigned char* XT = F.lds;
    LAS unsigned char* BT = F.lds + 65536;
    LAS float* WARR = (LAS float*)(F.lds + 98304) + w * 128;
    __syncthreads();
    { const int cg = lane & 7, ts = lane >> 3, ch = h * 64 + 8 * cg, sl = 64 * d + 8 * ts; float o[8][8];
      conv8<8>(PROJ + PC_XS + ch, cc * CHUNK + sl, cw + ch, cb + ch, o);
      bf16* xtg = (bf16*)(ws + WS_XT) + ((size_t)((b * NCHUNK + cc) * SSM_HEADS + h)) * 8192;
#pragma unroll
      for (int c = 0; c < 8; ++c) { const int p = 8 * cg + c, oc = 8 * d + ts;
          v4u pk; pk.x = cvt_pk_bf16(o[0][c], o[1][c]); pk.y = cvt_pk_bf16(o[2][c], o[3][c]); pk.z = cvt_pk_bf16(o[4][c], o[5][c]); pk.w = cvt_pk_bf16(o[6][c], o[7][c]);
          *(LAS v4u*)(XT + hl * 16384 + p * 256 + ((oc ^ (p & 15)) << 4)) = pk;
          *(v4u*)(xtg + p * 128 + sl) = pk; } }
    { const int cg = lane & 15, ts = lane >> 4, n0 = 8 * cg, sl = 16 * w + 4 * ts; float o[4][8];
      conv8<4>(PROJ + PC_B + g * 128 + n0, cc * CHUNK + sl, cw + 1024 + g * 128 + n0, cb + 1024 + g * 128 + n0, o);
#pragma unroll
      for (int c = 0; c < 8; ++c) { const int n = n0 + c, oc = sl >> 3; v2u pk; pk.x = cvt_pk_bf16(o[0][c], o[1][c]); pk.y = cvt_pk_bf16(o[2][c], o[3][c]);
          *(LAS v2u*)(BT + n * 256 + ((oc ^ (n & 15)) << 4) + (ts & 1) * 8) = pk; }
      if (half == 0) { bf16* bcg = (bf16*)(ws + WS_BC) + (size_t)(t0 + sl) * 512 + g * 128 + n0;
#pragma unroll
          for (int t = 0; t < 4; ++t) { v4u pk; pk.x = cvt_pk_bf16(o[t][0], o[t][1]); pk.y = cvt_pk_bf16(o[t][2], o[t][3]); pk.z = cvt_pk_bf16(o[t][4], o[t][5]); pk.w = cvt_pk_bf16(o[t][6], o[t][7]);
              *(v4u*)(bcg + (size_t)t * 512) = pk; } } }
    { const int cg = lane & 15, ts = lane >> 4, n0 = 8 * cg, sl = 64 * half + 8 * w + 2 * ts; float o[2][8];
      conv8<2>(PROJ + PC_C + g * 128 + n0, cc * CHUNK + sl, cw + 1280 + g * 128 + n0, cb + 1280 + g * 128 + n0, o);
      bf16* bcg = (bf16*)(ws + WS_BC) + (size_t)(t0 + sl) * 512 + 256 + g * 128 + n0;
#pragma unroll
      for (int t = 0; t < 2; ++t) { v4u pk; pk.x = cvt_pk_bf16(o[t][0], o[t][1]); pk.y = cvt_pk_bf16(o[t][2], o[t][3]); pk.z = cvt_pk_bf16(o[t][4], o[t][5]); pk.w = cvt_pk_bf16(o[t][6], o[t][7]);
          *(v4u*)(bcg + (size_t)t * 512) = pk; } }
    float total;
    { const float* DT = (const float*)(ws + WS_DT); const float bias = (d ? F.in[I_DTBB] : F.in[I_DTBF])[h]; const float A = -__expf((d ? F.in[I_ALOGB] : F.in[I_ALOGF])[h]);
      const float dt0 = softplus_f(DT[(size_t)(t0 + lane) * 32 + 16 * d + h] + bias), dt1 = softplus_f(DT[(size_t)(t0 + lane + 64) * 32 + 16 * d + h] + bias);
      const float a0 = dt0 * A, a1 = dt1 * A; float c0 = a0, c1 = a1;
#pragma unroll
      for (int o = 1; o < 64; o <<= 1) { const float u0 = __shfl_up(c0, o), u1 = __shfl_up(c1, o); if (lane >= o) { c0 += u0; c1 += u1; } }
      const float tot0 = __shfl(c0, 63); c1 += tot0; total = __shfl(c1, 63);
      const float X0 = d ? (total - c0 + a0) : c0, X1 = d ? (total - c1 + a1) : c1;
      WARR[lane] = dt0 * __expf(total - X0); WARR[lane + 64] = dt1 * __expf(total - X1);
      float* dta = (float*)(ws + WS_DTA);
      *(f32x2*)(dta + (size_t)(t0 + lane) * 64 + h * 4 + 2 * d) = (f32x2){dt0, X0};
      *(f32x2*)(dta + (size_t)(t0 + lane + 64) * 64 + h * 4 + 2 * d) = (f32x2){dt1, X1};
      if (lane == 0) ((float*)(ws + WS_CD))[((size_t)(b * NCHUNK + cc) * SSM_HEADS + h) * 2 + d] = __expf(total); }
    __syncthreads();
    { const int fr = lane & 15, fq = lane >> 4;
      bf16* st = (bf16*)(ws + WS_ST) + ((size_t)(((b * NCHUNK + cc) * SSM_HEADS + h) * 2 + d)) * 8192;
#pragma unroll 1
      for (int ih = 0; ih < 2; ++ih) {
          f32x4 acc[4][4];
#pragma unroll
          for (int i = 0; i < 4; ++i)
#pragma unroll
              for (int j = 0; j < 4; ++j) acc[i][j] = (f32x4){0.f, 0.f, 0.f, 0.f};
#pragma unroll
          for (int ks = 0; ks < 4; ++ks) { const int oc = 4 * ks + fq;
              const f32x4 w0 = *(const LAS f32x4*)(WARR + 8 * oc), w1 = *(const LAS f32x4*)(WARR + 8 * oc + 4);
              bf16x8 bfr[4];
#pragma unroll
              for (int j = 0; j < 4; ++j) { const int p = 16 * j + fr; const v4u raw = *(const LAS v4u*)(XT + hl * 16384 + p * 256 + ((oc ^ (p & 15)) << 4));
                  v4u sc; sc.x = cvt_pk_bf16(bf_lo(raw.x) * w0[0], bf_hi(raw.x) * w0[1]); sc.y = cvt_pk_bf16(bf_lo(raw.y) * w0[2], bf_hi(raw.y) * w0[3]);
                  sc.z = cvt_pk_bf16(bf_lo(raw.z) * w1[0], bf_hi(raw.z) * w1[1]); sc.w = cvt_pk_bf16(bf_lo(raw.w) * w1[2], bf_hi(raw.w) * w1[3]);
                  bfr[j] = __builtin_bit_cast(bf16x8, sc); }
#pragma unroll
              for (int i = 0; i < 4; ++i) { const int n = 16 * (4 * ih + i) + fr; const bf16x8 afr = *(const LAS bf16x8*)(BT + n * 256 + ((oc ^ (n & 15)) << 4));
#pragma unroll
                  for (int j = 0; j < 4; ++j) acc[i][j] = __builtin_amdgcn_mfma_f32_16x16x32_bf16(afr, bfr[j], acc[i][j], 0, 0, 0); }
          }
#pragma unroll
          for (int i = 0; i < 4; ++i)
#pragma unroll
              for (int j = 0; j < 4; ++j) { v2u pk; pk.x = cvt_pk_bf16(acc[i][j][0], acc[i][j][1]); pk.y = cvt_pk_bf16(acc[i][j][2], acc[i][j][3]); *(v2u*)(st + (16 * j + fr) * 128 + 16 * (4 * ih + i) + 4 * fq) = pk; }
      }
    }
}

__device__ __forceinline__ void ssd_scan_item(Frame& F, int item) {
    const int hf = item & 1, d = (item >> 1) & 1, h = (item >> 2) & 15, b = item >> 6;
    bf16* st = (bf16*)(F.ws + WS_ST); const float* cd = (const float*)(F.ws + WS_CD);
    const size_t i0 = (size_t)(b * NCHUNK * SSM_HEADS + h) * 2 + d;
    v4u* p0 = (v4u*)(st + i0 * 8192 + hf * 4096) + F.tid;
    constexpr size_t CS = (size_t)SSM_HEADS * 2 * 8192 / 8;
    float carry[8];
#pragma unroll
    for (int q = 0; q < 8; ++q) carry[q] = 0.f;
#pragma unroll 1
    for (int half = 0; half < 2; ++half) {
        v4u v[16];
#pragma unroll
        for (int j = 0; j < 16; ++j) { const int cc = d ? (NCHUNK - 1 - (16 * half + j)) : (16 * half + j); v[j] = p0[(size_t)cc * CS]; }
#pragma unroll
        for (int j = 0; j < 16; ++j) { const int cc = d ? (NCHUNK - 1 - (16 * half + j)) : (16 * half + j); const float dec = cd[i0 + (size_t)cc * SSM_HEADS * 2];
            v4u o; o.x = cvt_pk_bf16(carry[0], carry[1]); o.y = cvt_pk_bf16(carry[2], carry[3]); o.z = cvt_pk_bf16(carry[4], carry[5]); o.w = cvt_pk_bf16(carry[6], carry[7]);
            p0[(size_t)cc * CS] = o;
            carry[0] = carry[0] * dec + bf_lo(v[j].x); carry[1] = carry[1] * dec + bf_hi(v[j].x); carry[2] = carry[2] * dec + bf_lo(v[j].y); carry[3] = carry[3] * dec + bf_hi(v[j].y);
            carry[4] = carry[4] * dec + bf_lo(v[j].z); carry[5] = carry[5] * dec + bf_hi(v[j].z); carry[6] = carry[6] * dec + bf_lo(v[j].w); carry[7] = carry[7] * dec + bf_hi(v[j].w); }
    }
}

__device__ __forceinline__ void ssd_out_unit(Frame& F, int unit) {
    const int g = unit & 1, cc = (unit >> 1) & (NCHUNK - 1), b = unit >> 6;
    int lane = F.lane; asm volatile("" : "+v"(lane));
    const int w = F.wave, h = g * 8 + w, fr = lane & 15, fq = lane >> 4;
    const int t0 = b * SEQ + cc * CHUNK;
    unsigned char* ws = F.ws;
    const bf16* BC = (const bf16*)(ws + WS_BC) + (size_t)t0 * 512;
    LAS unsigned char* CB = F.lds;
    LAS f32x4* AR = (LAS f32x4*)(F.lds + 32768) + w * 128;
    LAS float* SSQ = (LAS float*)(F.lds + 49152);
    LAS unsigned char* CT = F.lds + 65536;
    __syncthreads();
    { f32x4 acc[8];
#pragma unroll
      for (int i = 0; i < 8; ++i) acc[i] = (f32x4){0.f, 0.f, 0.f, 0.f};
#pragma unroll
      for (int ks = 0; ks < 4; ++ks) { const int n0 = 32 * ks + 8 * fq;
          const bf16x8 cf = *(const bf16x8*)(BC + (size_t)(16 * w + fr) * 512 + 256 + g * 128 + n0);
          { const int l = 16 * w + fr; *(LAS bf16x8*)(CT + l * 256 + (((4 * ks + fq) ^ (l & 15)) << 4)) = cf; }
#pragma unroll
          for (int i = 0; i < 8; ++i) { const bf16x8 bfg = *(const bf16x8*)(BC + (size_t)(16 * i + fr) * 512 + g * 128 + n0);
              acc[i] = __builtin_amdgcn_mfma_f32_16x16x32_bf16(bfg, cf, acc[i], 0, 0, 0); } }
      const int l = 16 * w + fr;
#pragma unroll
      for (int i = 0; i < 8; ++i) { const int oc = 2 * i + (fq >> 1); v2u pk; pk.x = cvt_pk_bf16(acc[i][0], acc[i][1]); pk.y = cvt_pk_bf16(acc[i][2], acc[i][3]);
          *(LAS v2u*)(CB + l * 256 + ((oc ^ (l & 15)) << 4) + (fq & 1) * 8) = pk; } }
    { const f32x4* dta = (const f32x4*)(ws + WS_DTA); AR[lane] = dta[(size_t)(t0 + lane) * 16 + h]; AR[lane + 64] = dta[(size_t)(t0 + lane + 64) * 16 + h]; }
    __syncthreads();
    const float dsk = F.in[I_DSKIP][h];
    const bf16* xtg = (const bf16*)(ws + WS_XT) + ((size_t)((b * NCHUNK + cc) * SSM_HEADS + h)) * 8192;
    const bf16* Z = (const bf16*)(ws + WS_PROJ) + (size_t)t0 * NPROJ + PC_Z + h * 64;
    bf16* YC = (bf16*)(ws + WS_YCAT) + (size_t)t0 * DM + h * 64;
#pragma unroll 1
    for (int hf = 0; hf < 2; ++hf) {
        f32x4 acc[4][4];
#pragma unroll
        for (int pt = 0; pt < 4; ++pt)
#pragma unroll
            for (int lt = 0; lt < 4; ++lt) acc[pt][lt] = (f32x4){0.f, 0.f, 0.f, 0.f};
        int fro = fr; asm volatile("" : "+v"(fro));
        const bf16* pv0 = (const bf16*)(ws + WS_ST) + ((size_t)(((b * NCHUNK + cc) * SSM_HEADS + h) * 2)) * 8192 + fro * 128 + 8 * fq;
        bf16x8 pq[3][4];
#define SSD_PQ(it) do { _Pragma("unroll") for (int q = 0; q < 4; ++q) pq[(it) % 3][q] = *(const bf16x8*)(pv0 + ((it) >> 2) * 8192 + (16 * q) * 128 + 32 * ((it) & 3)); } while (0)
        bf16x8 xfn[4];
#pragma unroll
        for (int pt = 0; pt < 4; ++pt) xfn[pt] = *(const bf16x8*)(xtg + (16 * pt + fro) * 128 + 8 * fq);
#pragma unroll 1
        for (int ks = 0; ks < 4; ++ks) { const int s0 = 32 * ks + 8 * fq;
            bf16x8 xf[4];
#pragma unroll
            for (int pt = 0; pt < 4; ++pt) xf[pt] = xfn[pt];
            if (ks < 3) {
#pragma unroll
                for (int pt = 0; pt < 4; ++pt) xfn[pt] = *(const bf16x8*)(xtg + (16 * pt + fro) * 128 + s0 + 32); }
            f32x4 as[8];
#pragma unroll
            for (int e = 0; e < 8; ++e) as[e] = AR[s0 + e];
#pragma unroll
            for (int lt = 0; lt < 4; ++lt) { const int l = 16 * (4 * hf + lt) + fr; const f32x4 al = AR[l];
                const v4u raw = *(const LAS v4u*)(CB + l * 256 + (((4 * ks + fq) ^ (l & 15)) << 4));
                float cbv[8]; cbv[0] = bf_lo(raw.x); cbv[1] = bf_hi(raw.x); cbv[2] = bf_lo(raw.y); cbv[3] = bf_hi(raw.y); cbv[4] = bf_lo(raw.z); cbv[5] = bf_hi(raw.z); cbv[6] = bf_lo(raw.w); cbv[7] = bf_hi(raw.w);
                float sv[8];
                const int rel = 16 * (4 * hf + lt) - 32 * ks;
                if (rel >= 32) {
#pragma unroll
                    for (int e = 0; e < 8; ++e) sv[e] = cbv[e] * (as[e][0] * __expf(al[1] - as[e][1]));
                } else if (rel <= -16) {
#pragma unroll
                    for (int e = 0; e < 8; ++e) sv[e] = cbv[e] * (as[e][2] * __expf(al[3] - as[e][3]));
                } else {
#pragma unroll
                    for (int e = 0; e < 8; ++e) { const int s = s0 + e; const bool lo = s < l, eq = s == l;
                        const float arg = lo ? (al[1] - as[e][1]) : (al[3] - as[e][3]);
                        float wgt = (lo ? as[e][0] : as[e][2]) * __expf(arg);
                        wgt += eq ? as[e][0] : 0.f;
                        sv[e] = cbv[e] * wgt + (eq ? dsk : 0.f); }
                }
                v4u pk; pk.x = cvt_pk_bf16(sv[0], sv[1]); pk.y = cvt_pk_bf16(sv[2], sv[3]); pk.z = cvt_pk_bf16(sv[4], sv[5]); pk.w = cvt_pk_bf16(sv[6], sv[7]);
                const bf16x8 sf = __builtin_bit_cast(bf16x8, pk);
#pragma unroll
                for (int pt = 0; pt < 4; ++pt) acc[pt][lt] = __builtin_amdgcn_mfma_f32_16x16x32_bf16(xf[pt], sf, acc[pt][lt], 0, 0, 0); }
        }
        SSD_PQ(0); SSD_PQ(1);
        v2u zr[4][4];
#pragma unroll
        for (int lt = 0; lt < 4; ++lt)
#pragma unroll
            for (int pt = 0; pt < 4; ++pt) zr[lt][pt] = *(const v2u*)(Z + (size_t)(16 * (4 * hf + lt) + fro) * NPROJ + 16 * pt + 4 * fq);
        { float ef[4], eb[4];
#pragma unroll
          for (int lt = 0; lt < 4; ++lt) { const f32x4 al = AR[16 * (4 * hf + lt) + fr]; ef[lt] = __expf(al[1]); eb[lt] = __expf(al[3]); }
#pragma unroll
          for (int it = 0; it < 8; ++it) {
              if (it + 2 < 8) SSD_PQ(it + 2);
              __builtin_amdgcn_sched_barrier(0);
#pragma unroll
              for (int lt = 0; lt < 4; ++lt) { const int l = 16 * (4 * hf + lt) + fr; const float e = (it >> 2) ? eb[lt] : ef[lt];
                  const v4u raw = *(const LAS v4u*)(CT + l * 256 + (((4 * (it & 3) + fq) ^ (l & 15)) << 4));
                  v4u pk; pk.x = cvt_pk_bf16(bf_lo(raw.x) * e, bf_hi(raw.x) * e); pk.y = cvt_pk_bf16(bf_lo(raw.y) * e, bf_hi(raw.y) * e); pk.z = cvt_pk_bf16(bf_lo(raw.z) * e, bf_hi(raw.z) * e); pk.w = cvt_pk_bf16(bf_lo(raw.w) * e, bf_hi(raw.w) * e);
                  const bf16x8 cf = __builtin_bit_cast(bf16x8, pk);
#pragma unroll
                  for (int pt = 0; pt < 4; ++pt) acc[pt][lt] = __builtin_amdgcn_mfma_f32_16x16x32_bf16(pq[it % 3][pt], cf, acc[pt][lt], 0, 0, 0); }
              __builtin_amdgcn_sched_barrier(0);
          } }
#undef SSD_PQ
#pragma unroll
        for (int lt = 0; lt < 4; ++lt) { const int l = 16 * (4 * hf + lt) + fr; float s = 0.f;
#pragma unroll
            for (int pt = 0; pt < 4; ++pt) { const v2u zv = zr[lt][pt];
                f32x4 y = acc[pt][lt]; y[0] *= silu_f(bf_lo(zv.x)); y[1] *= silu_f(bf_hi(zv.x)); y[2] *= silu_f(bf_lo(zv.y)); y[3] *= silu_f(bf_hi(zv.y)); acc[pt][lt] = y;
                s += y[0] * y[0] + y[1] * y[1] + y[2] * y[2] + y[3] * y[3]; }
            s += __shfl_xor(s, 16); s += __shfl_xor(s, 32);
            if (fq == 0) SSQ[l * 8 + w] = s; }
        __syncthreads();
#pragma unroll
        for (int lt = 0; lt < 4; ++lt) { const int l = 16 * (4 * hf + lt) + fr; const f32x4 a = *(const LAS f32x4*)(SSQ + l * 8), c = *(const LAS f32x4*)(SSQ + l * 8 + 4);
            float rs = rsqrtf((a[0] + a[1] + a[2] + a[3] + c[0] + c[1] + c[2] + c[3]) * (1.f / 512.f) + RMS_EPS);
            if (DBG_NO_SSM) rs = 0.f;
#pragma unroll
            for (int pt = 0; pt < 4; ++pt) { const f32x4 y = acc[pt][lt] * rs; v2u pk; pk.x = cvt_pk_bf16(y[0], y[1]); pk.y = cvt_pk_bf16(y[2], y[3]);
                *(v2u*)(YC + (size_t)l * DM + 16 * pt + 4 * fq) = pk; } }
    }
}

__device__ __forceinline__ void att_norm_rows(Frame& F) {
    const int gw = F.c * NWAVES + F.wave, NGW = F.G * NWAVES, lane = F.lane;
    const bf16* O = (const bf16*)(F.ws + WS_O); bf16* YC = (bf16*)(F.ws + WS_YCAT);
    for (int m = gw; m < NT; m += NGW) { const v4u r = *((const v4u*)(O + (size_t)m * 1024) + lane);
        const v4u r2 = *((const v4u*)(O + (size_t)m * 1024) + lane + 64);
        float v[16]; v[0] = bf_lo(r.x); v[1] = bf_hi(r.x); v[2] = bf_lo(r.y); v[3] = bf_hi(r.y); v[4] = bf_lo(r.z); v[5] = bf_hi(r.z); v[6] = bf_lo(r.w); v[7] = bf_hi(r.w);
        v[8] = bf_lo(r2.x); v[9] = bf_hi(r2.x); v[10] = bf_lo(r2.y); v[11] = bf_hi(r2.y); v[12] = bf_lo(r2.z); v[13] = bf_hi(r2.z); v[14] = bf_lo(r2.w); v[15] = bf_hi(r2.w);
        float s = 0.f;
#pragma unroll
        for (int j = 0; j < 16; ++j) s += v[j] * v[j];
        float rs = rsqrtf(wave_sum(s) * (1.f / 1024.f) + RMS_EPS);
        if (DBG_NO_ATT) rs = 0.f;
        v4u o, o2; o.x = cvt_pk_bf16(v[0] * rs, v[1] * rs); o.y = cvt_pk_bf16(v[2] * rs, v[3] * rs); o.z = cvt_pk_bf16(v[4] * rs, v[5] * rs); o.w = cvt_pk_bf16(v[6] * rs, v[7] * rs);
        o2.x = cvt_pk_bf16(v[8] * rs, v[9] * rs); o2.y = cvt_pk_bf16(v[10] * rs, v[11] * rs); o2.z = cvt_pk_bf16(v[12] * rs, v[13] * rs); o2.w = cvt_pk_bf16(v[14] * rs, v[15] * rs);
        *((v4u*)(YC + (size_t)m * DM + D_SSM) + lane) = o; *((v4u*)(YC + (size_t)m * DM + D_SSM) + lane + 64) = o2; }
}

namespace att {
constexpr int NW = 8, QBLK = 32, KVBLK = 64;
constexpr float SCALE = 0.07216878364870322f;
constexpr float THR = 8.f;
constexpr int SHM_V = KVBLK * 128 * 2, SHM_K = KVBLK * QKD * 2;
constexpr int SHM_ATTN = 3 * SHM_V + 3 * SHM_K + NW * 64 * 4;
#define KSW(row, ch) ((row) * 384 + ((((ch)) ^ (((row) >> 1) & 7)) << 4))
#define SBAR() __builtin_amdgcn_sched_barrier(0)
__device__ __forceinline__ int crow(int r, int hi) { return (r & 3) + 8 * (r >> 2) + 4 * hi; }
__device__ __forceinline__ void partialSM(f32x16& p0, f32x16& p1, float& m_reg, float& mn, float& alpha) {
    constexpr float C = SCALE * 1.4426950408889634f;
    float pmax = p0[0];
#pragma unroll
    for (int r = 1; r < 16; ++r) pmax = fmaxf(pmax, p0[r]);
#pragma unroll
    for (int r = 0; r < 16; ++r) pmax = fmaxf(pmax, p1[r]);
    { auto rr = __builtin_amdgcn_permlane32_swap(__float_as_uint(pmax), __float_as_uint(pmax), false, false);
      pmax = fmaxf(__uint_as_float(rr[0]), __uint_as_float(rr[1])); }
    if (__builtin_expect(__all(pmax - m_reg <= THR / SCALE), 1)) { mn = m_reg; alpha = 1.f; }
    else { mn = fmaxf(m_reg, pmax); alpha = __builtin_amdgcn_exp2f((m_reg - mn) * C); m_reg = mn; }
    const float mnC = -mn * C;
#pragma unroll
    for (int r = 0; r < 16; ++r) p0[r] = fmaf(p0[r], C, mnC);
#pragma unroll
    for (int r = 0; r < 16; ++r) p1[r] = fmaf(p1[r], C, mnC);
#pragma unroll
    for (int r = 0; r < 16; ++r) p0[r] = __builtin_amdgcn_exp2f(p0[r]);
}
__device__ __forceinline__ void finishSM(f32x16& p0, f32x16& p1, float alpha, float& l_reg, bf16x8& pa0, bf16x8& pa1, bf16x8& pa2, bf16x8& pa3) {
#pragma unroll
    for (int r = 0; r < 16; ++r) p1[r] = __builtin_amdgcn_exp2f(p1[r]);
    float ps = 0;
#pragma unroll
    for (int r = 0; r < 16; ++r) ps += p0[r];
#pragma unroll
    for (int r = 0; r < 16; ++r) ps += p1[r];
    { auto rr = __builtin_amdgcn_permlane32_swap(__float_as_uint(ps), __float_as_uint(ps), false, false);
      ps = __uint_as_float(rr[0]) + __uint_as_float(rr[1]); }
    l_reg = l_reg * alpha + ps;
#define PK4(P, BASE, OUT) do { unsigned a0 = cvt_pk_bf16(P[BASE + 0], P[BASE + 1]), a1 = cvt_pk_bf16(P[BASE + 2], P[BASE + 3]);   \
    unsigned b0 = cvt_pk_bf16(P[BASE + 4], P[BASE + 5]), b1 = cvt_pk_bf16(P[BASE + 6], P[BASE + 7]);                              \
    auto r0 = __builtin_amdgcn_permlane32_swap(a0, b0, false, false); auto r1 = __builtin_amdgcn_permlane32_swap(a1, b1, false, false); \
    v4u w_ = {r0[0], r1[0], r0[1], r1[1]}; OUT = __builtin_bit_cast(bf16x8, w_); } while (0)
    PK4(p0, 0, pa0); PK4(p0, 8, pa1); PK4(p1, 0, pa2); PK4(p1, 8, pa3);
#undef PK4
}
__device__ __forceinline__ void qkt(f32x16& p0, f32x16& p1, const LAS unsigned char* Ks, const bf16x8 (&qr)[12], int r32, int hi) {
    p0 = f32x16{}; p1 = f32x16{};
#pragma unroll
    for (int d0 = 0; d0 < 12; ++d0) { const int ch = d0 * 2 + hi;
        const bf16x8 b0 = *(const LAS bf16x8*)(Ks + KSW(r32, ch));
        const bf16x8 b1 = *(const LAS bf16x8*)(Ks + 32 * 384 + KSW(r32, ch));
        p0 = __builtin_amdgcn_mfma_f32_32x32x16_bf16(b0, qr[d0], p0, 0, 0, 0);
        p1 = __builtin_amdgcn_mfma_f32_32x32x16_bf16(b1, qr[d0], p1, 0, 0, 0); }
}
__device__ __forceinline__ int v_st(int k, int c) { const int kk = (k & ~0xC) | ((k & 4) << 1) | ((k & 8) >> 1); return ((kk >> 3) * 4 + (c >> 5)) * 512 + ((kk & 7) * 32 + (c & 31)) * 2; }
__device__ __forceinline__ int v_rd_base(int lane) { return ((lane & 3) << 3) | (((lane >> 2) & 3) << 6) | (((lane >> 4) & 1) << 5) | (((lane >> 5) & 1) << 8); }
constexpr int v_rd_off(int d0, int ks, int half) { return d0 * 512 + ks * 4096 + half * 2048; }
template <int OFF> __device__ __forceinline__ s16x4 tr_read(int vb) {
    s16x4 r; asm volatile("ds_read_b64_tr_b16 %0, %1 offset:%2" : "=&v"(r) : "v"(vb), "i"(OFF) : "memory"); return r;
}
template <int D0> __device__ __forceinline__ void pv_one(f32x16& od, int vb, bf16x8 pa0, bf16x8 pa1, bf16x8 pa2, bf16x8 pa3) {
    const s16x4 l0 = tr_read<v_rd_off(D0, 0, 0)>(vb), h0 = tr_read<v_rd_off(D0, 0, 1)>(vb), l1 = tr_read<v_rd_off(D0, 1, 0)>(vb), h1 = tr_read<v_rd_off(D0, 1, 1)>(vb);
    const s16x4 l2 = tr_read<v_rd_off(D0, 2, 0)>(vb), h2 = tr_read<v_rd_off(D0, 2, 1)>(vb), l3 = tr_read<v_rd_off(D0, 3, 0)>(vb), h3 = tr_read<v_rd_off(D0, 3, 1)>(vb);
    asm volatile("s_waitcnt lgkmcnt(0)" ::: "memory"); SBAR();
#define PK(L, H) (bf16x8){L[0], L[1], L[2], L[3], H[0], H[1], H[2], H[3]}
    od = __builtin_amdgcn_mfma_f32_32x32x16_bf16(pa0, PK(l0, h0), od, 0, 0, 0);
    od = __builtin_amdgcn_mfma_f32_32x32x16_bf16(pa1, PK(l1, h1), od, 0, 0, 0);
    od = __builtin_amdgcn_mfma_f32_32x32x16_bf16(pa2, PK(l2, h2), od, 0, 0, 0);
    od = __builtin_amdgcn_mfma_f32_32x32x16_bf16(pa3, PK(l3, h3), od, 0, 0, 0);
#undef PK
}
__device__ __forceinline__ void pv_d0(f32x16* o, int vb, bf16x8 pa0, bf16x8 pa1, bf16x8 pa2, bf16x8 pa3) {
    pv_one<0>(o[0], vb, pa0, pa1, pa2, pa3); pv_one<1>(o[1], vb, pa0, pa1, pa2, pa3); pv_one<2>(o[2], vb, pa0, pa1, pa2, pa3); pv_one<3>(o[3], vb, pa0, pa1, pa2, pa3);
}
__device__ __forceinline__ void attn_unit(const bf16* __restrict__ Qb, const bf16* __restrict__ KNh, const bf16* __restrict__ KPb, const bf16* __restrict__ Vh, bf16* __restrict__ Ob, LAS unsigned char* lds) {
    int tid = threadIdx.x; asm volatile("" : "+v"(tid));
    const int wid = __builtin_amdgcn_readfirstlane(tid >> 6), lane = tid & 63, r32 = lane & 31, hi = lane >> 5;
    constexpr int NSLOT = 3;
    LAS unsigned char* V_lds = lds; LAS unsigned char* K_lds = lds + NSLOT * SHM_V;
    LAS float* wsf = (LAS float*)(lds + NSLOT * (SHM_V + SHM_K)) + wid * 64; LAS float* li_l = wsf; LAS float* al_l = wsf + 32;
    float m_reg = -1e30f, l_reg = 0; f32x16 o[4] = {}; bf16x8 qr[12];
    const bf16* Qw = Qb + (size_t)(wid * QBLK + r32) * QKD + hi * 8;
#pragma unroll
    for (int d0 = 0; d0 < 12; ++d0) qr[d0] = *(const bf16x8*)(Qw + d0 * 16);
    const char* kp[3]; unsigned kst[3]; const char* vp[2];
#pragma unroll
    for (int i = 0; i < 3; ++i) { const int P = (8 * i + wid) * 64 + lane, row = P / 24, chp = P - row * 24, ch = chp ^ ((row >> 1) & 7);
        if (ch < 16) { kp[i] = (const char*)(KNh + (size_t)row * 128 + ch * 8); kst[i] = KVBLK * 128 * 2; } else { kp[i] = (const char*)(KPb + (size_t)row * 64 + (ch - 16) * 8); kst[i] = KVBLK * 64 * 2; } }
#pragma unroll
    for (int i = 0; i < 2; ++i) { const int P = (8 * i + wid) * 64 + lane, s = P >> 5, within = P & 31, kk = (s >> 2) * 8 + (within >> 2), c = (s & 3) * 32 + (within & 3) * 8;
        const int k = (kk & ~0xC) | ((kk & 4) << 1) | ((kk & 8) >> 1);
        vp[i] = (const char*)(Vh + (size_t)k * 128 + c); }
    const int vb0 = (int)(uintptr_t)V_lds + v_rd_base(lane);
#define DMA_TILE(slot) do { _Pragma("unroll") for (int i_ = 0; i_ < 3; ++i_) { __builtin_amdgcn_global_load_lds((const unsigned*)kp[i_], (LAS unsigned*)(K_lds + (slot) * SHM_K + (8 * i_ + wid) * 1024), 16, 0, 0); kp[i_] += kst[i_]; } \
    _Pragma("unroll") for (int i_ = 0; i_ < 2; ++i_) { __builtin_amdgcn_global_load_lds((const unsigned*)vp[i_], (LAS unsigned*)(V_lds + (slot) * SHM_V + (8 * i_ + wid) * 1024), 16, 0, 0); vp[i_] += KVBLK * 128 * 2; } } while (0)
#define SWAIT() asm volatile("s_waitcnt vmcnt(0)" ::: "memory")
#define RESC(a) do { if (__any((a) < 1.f)) { if (hi == 0) al_l[r32] = (a); asm volatile("s_waitcnt lgkmcnt(0)" ::: "memory"); \
    _Pragma("unroll") for (int d = 0; d < 4; ++d) _Pragma("unroll") for (int r = 0; r < 16; ++r) o[d][r] *= al_l[crow(r, hi)]; } } while (0)
    f32x16 p0, p1; float mn, al; bf16x8 pa0, pa1, pa2, pa3; constexpr int NTL = SEQ / KVBLK;
    const int grp = wid >> 2;
    __syncthreads();
    DMA_TILE(0); DMA_TILE(1); SWAIT();
    __syncthreads();
#define STAGE_NEXT(j, s2) do { SWAIT(); if ((j) + 2 < NTL) DMA_TILE(s2); } while (0)
#define SM_PV(s0) do { partialSM(p0, p1, m_reg, mn, al); RESC(al); finishSM(p0, p1, al, l_reg, pa0, pa1, pa2, pa3); SBAR(); pv_d0(o, vb0 + (s0) * SHM_V, pa0, pa1, pa2, pa3); } while (0)
    if (grp == 0) {
        int s0 = 0, s2 = 2;
#pragma unroll 1
        for (int j = 0; j < NTL; ++j) {
            SBAR(); qkt(p0, p1, K_lds + s0 * SHM_K, qr, r32, hi);
            __syncthreads();
            STAGE_NEXT(j, s2);
            SM_PV(s0);
            __syncthreads();
            s0 = (s0 == 2) ? 0 : s0 + 1; s2 = (s2 == 2) ? 0 : s2 + 1;
        }
        __syncthreads();
    } else {
        int s0 = 0, s2 = 2;
        __syncthreads();
#pragma unroll 1
        for (int j = 0; j < NTL; ++j) {
            STAGE_NEXT(j, s2);
            SBAR(); qkt(p0, p1, K_lds + s0 * SHM_K, qr, r32, hi);
            __syncthreads();
            SM_PV(s0);
            __syncthreads();
            s0 = (s0 == 2) ? 0 : s0 + 1; s2 = (s2 == 2) ? 0 : s2 + 1;
        }
    }
#undef STAGE_NEXT
#undef SM_PV
    if (hi == 0) li_l[r32] = l_reg; asm volatile("s_waitcnt lgkmcnt(0)" ::: "memory");
    float rli[16];
#pragma unroll
    for (int r = 0; r < 16; ++r) rli[r] = __builtin_amdgcn_rcpf(li_l[crow(r, hi)]);
    bf16* Ow = Ob + (size_t)(wid * QBLK) * 1024;
#pragma unroll
    for (int r = 0; r < 16; ++r) { const int orow = crow(r, hi);
#pragma unroll
        for (int d0 = 0; d0 < 4; ++d0) Ow[(size_t)orow * 1024 + d0 * 32 + r32] = (bf16)(cvt_pk_bf16(o[d0][r] * rli[r], 0.f) & 0xffffu); }
#undef DMA_TILE
#undef SWAIT
#undef RESC
}
}

typedef int i32x4 __attribute__((ext_vector_type(4)));
__device__ __forceinline__ void moe_tables(Frame& F, bool need_bases) {
    volatile LAS int* M = (volatile LAS int*)F.MISC;
    const int* UC = (const int*)(F.ws + WS_RTS);
    LAS int* SC = (LAS int*)F.lds;
    __syncthreads();
    { const int e4 = F.tid & 7, ul = F.tid >> 3; const int c = F.c, G = F.G;
      i32x4 acc[5];
#pragma unroll
      for (int j = 0; j < 5; ++j) acc[j] = (i32x4){0, 0, 0, 0};
#pragma unroll 4
      for (int i = 0; i < 16; ++i) { const int u = ul + 64 * i; const i32x4 v = *(const i32x4*)(UC + u * 32 + 4 * e4);
          acc[0] += v;
          if (need_bases) {
#pragma unroll
              for (int j = 0; j < 4; ++j) acc[1 + j] += (u < c + j * G) ? v : (i32x4){0, 0, 0, 0}; } }
#pragma unroll
      for (int j = 0; j < 5; ++j)
#pragma unroll
          for (int r = 0; r < 4; ++r) { int x = acc[j][r]; x += __shfl_xor(x, 8); x += __shfl_xor(x, 16); x += __shfl_xor(x, 32); acc[j][r] = x; }
      if (F.lane < 8) {
#pragma unroll
          for (int j = 0; j < 5; ++j) *(LAS i32x4*)(SC + (F.wave * 5 + j) * 32 + 4 * e4) = acc[j]; } }
    __syncthreads();
    if (F.tid < 160) { const int j = F.tid >> 5, e = F.tid & 31; int s = 0;
#pragma unroll
        for (int w = 0; w < 8; ++w) s += SC[(w * 5 + j) * 32 + e];
        if (j == 0) M[16 + e] = s; else M[960 + 32 * (j - 1) + e] = s; }
    __syncthreads();
    if (F.tid < 64) { const int e = F.lane & 31; const int pd = (M[16 + e] + 255) & ~255; int inc = pd;
#pragma unroll
        for (int o = 1; o < 32; o <<= 1) { const int v = __shfl_up(inc, o, 32); if ((F.lane & 31) >= o) inc += v; }
        const int off = inc - pd;
        if (F.lane < 32) { M[64 + e] = off; for (int t = off >> 8; t < (inc >> 8); ++t) M[128 + t] = e; if (e == NEXP - 1) M[48] = inc >> 8; } }
    __syncthreads();
}

struct RStep { v4u h[4]; f32x4 g[2]; bf16x8 w[4]; };
template <int MODE = 0>
__device__ __forceinline__ void router_phase(Frame& F) {
    const int lane = F.lane, fr = lane & 15, fq = lane >> 4, w = F.wave;
    unsigned char* ws = F.ws;
    const bf16* H = (const bf16*)(ws + WS_H); const float* n2 = F.in[I_NORM2];
    const float* ss2p = (const float*)(ws + WS_SS2P);
    unsigned char* XN8 = ws + WS_XN;
    LAS unsigned char* stg = F.lds + w * 16384;
    LAS float* LG = (LAS float*)(F.lds + w * 16384 + 8192);
    int* tok_e = (int*)(ws + WS_TOKE); int* tok_p = (int*)(ws + WS_TOKP); float* tok_g = (float*)(ws + WS_TOKG); int* uc = (int*)(ws + WS_RTS);
    const int iters = (NT / 64 + F.G - 1) / F.G;
    for (int it = 0; it < iters; ++it) {
        const int blk = it * F.G + F.c; const bool valid = blk < NT / 64;
        const int tok0 = 64 * (valid ? blk : 0);
        float rs[4];
#pragma unroll
        for (int tf = 0; tf < 4; ++tf) { const float* pz = ss2p + (size_t)(tok0 + 16 * tf + fr) * 32 + 8 * fq; const f32x4 a = *(const f32x4*)pz, b = *(const f32x4*)(pz + 4);
            float ssum = ((a[0] + a[1]) + (a[2] + a[3])) + ((b[0] + b[1]) + (b[2] + b[3])); ssum += __shfl_xor(ssum, 16); ssum += __shfl_xor(ssum, 32);
            rs[tf] = rsqrtf(ssum * (1.f / DM) + RMS_EPS); }
        int kofs = w * 256 + 8 * fq;
        asm volatile("" : "+v"(kofs));
        const bf16* hrow = H + (size_t)(tok0 + fr) * DM + kofs;
        const bf16* wh0 = (const bf16*)(ws + WS_WRT) + (size_t)fr * DM + kofs;
        f32x4 acc[4][2];
#pragma unroll
        for (int tf = 0; tf < 4; ++tf) { acc[tf][0] = (f32x4){0.f, 0.f, 0.f, 0.f}; acc[tf][1] = (f32x4){0.f, 0.f, 0.f, 0.f}; }
        auto load = [&](RStep& b, int s) {
#pragma unroll
            for (int tf = 0; tf < 4; ++tf) b.h[tf] = *(const v4u*)(hrow + (size_t)(16 * tf) * DM + 32 * s);
            b.g[0] = *(const f32x4*)(n2 + kofs + 32 * s); b.g[1] = *(const f32x4*)(n2 + kofs + 32 * s + 4);
            b.w[0] = *(const bf16x8*)(wh0 + 32 * s); b.w[1] = *(const bf16x8*)(wh0 + 16 * DM + 32 * s); b.w[2] = *(const bf16x8*)(wh0 + NEXP * DM + 32 * s); b.w[3] = *(const bf16x8*)(wh0 + (NEXP + 16) * DM + 32 * s); };
        auto compute = [&](const RStep& b, int s) {
            const f32x4 g0 = b.g[0] * X8_SCALE, g1 = b.g[1] * X8_SCALE;
#pragma unroll
            for (int tf = 0; tf < 4; ++tf) { const v4u hx = b.h[tf]; const float r = rs[tf];
                const f32x4 ha = (f32x4){bf_lo(hx.x), bf_hi(hx.x), bf_lo(hx.y), bf_hi(hx.y)}, hb = (f32x4){bf_lo(hx.z), bf_hi(hx.z), bf_lo(hx.w), bf_hi(hx.w)};
                { v2u o; o.x = pk4_fp8(ha[0] * r * g0[0], ha[1] * r * g0[1], ha[2] * r * g0[2], ha[3] * r * g0[3]); o.y = pk4_fp8(hb[0] * r * g1[0], hb[1] * r * g1[1], hb[2] * r * g1[2], hb[3] * r * g1[3]);
                  *(LAS v2u*)(stg + (16 * tf + fr) * 256 + ((s ^ (fr & 7)) << 5) + 8 * fq) = o; }
                const bf16x8 bh = __builtin_bit_cast(bf16x8, hx);
                acc[tf][0] = __builtin_amdgcn_mfma_f32_16x16x32_bf16(b.w[0], bh, acc[tf][0], 0, 0, 0); acc[tf][1] = __builtin_amdgcn_mfma_f32_16x16x32_bf16(b.w[1], bh, acc[tf][1], 0, 0, 0);
                acc[tf][0] = __builtin_amdgcn_mfma_f32_16x16x32_bf16(b.w[2], bh, acc[tf][0], 0, 0, 0); acc[tf][1] = __builtin_amdgcn_mfma_f32_16x16x32_bf16(b.w[3], bh, acc[tf][1], 0, 0, 0); } };
        if (valid) {
            RStep A, B; load(A, 0);
#pragma unroll
            for (int s = 0; s < 8; s += 2) { load(B, s + 1); SBAR(); compute(A, s); SBAR(); if (s + 2 < 8) load(A, s + 2); SBAR(); compute(B, s + 1); SBAR(); }
            LDS_WAIT(); asm volatile("" ::: "memory");
#pragma unroll
            for (int i = 0; i < 16; ++i) { const int t = 4 * i + fq, j = fr;
                *(v4u*)(XN8 + (size_t)(tok0 + t) * DM + w * 256 + j * 16) = *(const LAS v4u*)(stg + t * 256 + (((j >> 1) ^ (t & 7)) << 5) + (j & 1) * 16); }
            LDS_WAIT(); asm volatile("" ::: "memory");
#pragma unroll
            for (int tf = 0; tf < 4; ++tf) { *(LAS f32x4*)(stg + ((16 * tf + fr) * 32 + 4 * fq) * 4) = acc[tf][0]; *(LAS f32x4*)(stg + ((16 * tf + fr) * 32 + 16 + 4 * fq) * 4) = acc[tf][1]; }
        }
        __syncthreads();
        if (valid && w < 4) {
        const int u = blk * 4 + w;
        f32x4 acc0 = (f32x4){0.f, 0.f, 0.f, 0.f}, acc1 = (f32x4){0.f, 0.f, 0.f, 0.f};
#pragma unroll
        for (int ww = 0; ww < 8; ++ww) { const LAS unsigned char* pp = F.lds + ww * 16384 + ((16 * w + fr) * 32 + 4 * fq) * 4; acc0 += *(const LAS f32x4*)pp; acc1 += *(const LAS f32x4*)(pp + 64); }
        const float rsu = (w == 0) ? rs[0] : (w == 1) ? rs[1] : (w == 2) ? rs[2] : rs[3];
        *(LAS f32x4*)(LG + fr * 32 + 4 * fq) = acc0 * rsu; *(LAS f32x4*)(LG + fr * 32 + 16 + 4 * fq) = acc1 * rsu;
        LDS_WAIT(); asm volatile("" ::: "memory");
        {
            const float* br = F.in[I_BR]; float v[32];
#pragma unroll
            for (int e = 0; e < 32; ++e) v[e] = LG[(lane & 15) * 32 + e] + br[e];
            unsigned taken = 0u; float tv[4]; int te[4];
#pragma unroll
            for (int k = 0; k < 4; ++k) { float best = -3.0e38f; int bi = 0;
#pragma unroll
                for (int e = 0; e < 32; ++e) { const bool ok = !((taken >> e) & 1u) && v[e] > best; best = ok ? v[e] : best; bi = ok ? e : bi; }
                taken |= 1u << bi; tv[k] = best; te[k] = (lane < 16) ? bi : -1; }
            int rk[4] = {0, 0, 0, 0}, myc = 0; const unsigned long long low = (1ull << lane) - 1ull;
#pragma unroll 2
            for (int e = 0; e < 32; ++e) {
                const unsigned long long b0 = __ballot(te[0] == e), b1 = __ballot(te[1] == e), b2 = __ballot(te[2] == e), b3 = __ballot(te[3] == e);
                const int lower = __popcll(b0 & low) + __popcll(b1 & low) + __popcll(b2 & low) + __popcll(b3 & low);
                const int cnt = __popcll(b0) + __popcll(b1) + __popcll(b2) + __popcll(b3);
#pragma unroll
                for (int k = 0; k < 4; ++k) rk[k] = (te[k] == e) ? lower : rk[k];
                myc = (lane == e) ? cnt : myc; }
            if (lane < 32) uc[u * 32 + lane] = myc;
            if (lane < 16) {
                const float e1 = __expf(tv[1] - tv[0]), e2 = __expf(tv[2] - tv[0]), e3 = __expf(tv[3] - tv[0]); const float inv = 1.f / (1.f + e1 + e2 + e3);
                const float gk[4] = {inv, e1 * inv, e2 * inv, e3 * inv};
                const int tk = 16 * u + lane;
#pragma unroll
                for (int k = 0; k < 4; ++k) { tok_e[tk * 4 + k] = te[k]; tok_p[tk * 4 + k] = rk[k]; tok_g[tk * 4 + k] = gk[k]; }
            }
        }
        LDS_WAIT(); asm volatile("" ::: "memory");
        }
        __syncthreads();
    }
}

__device__ __forceinline__ void gather_phase(Frame& F) {
    volatile LAS int* M = (volatile LAS int*)F.MISC;
    unsigned char* ws = F.ws; const int* tok_e = (const int*)(ws + WS_TOKE); const int* tok_p = (const int*)(ws + WS_TOKP); int* tok_r = (int*)(ws + WS_TOKR); int* rtok = (int*)(ws + WS_XG);
    if (F.c < NEXP) { const int cnt = M[16 + F.c], st = M[64 + F.c], pd = (cnt + 255) & ~255; for (int r = cnt + F.tid; r < pd; r += NWAVES * 64) rtok[st + r] = 0; }
    for (int ju = 0; ju < 4; ++ju) { const int u = F.c + ju * F.G; if (u >= NT / 16) break;
        if (F.tid < 64) { const int i = 64 * u + F.tid, e = tok_e[i], row = M[64 + e] + M[960 + 32 * ju + e] + tok_p[i];
            tok_r[i] = row; rtok[row] = i >> 2; }
    }
}

__device__ __forceinline__ void final_phase(Frame& F) {
    const int gw = F.c * NWAVES + F.wave, NGW = F.G * NWAVES, lane = F.lane;
    unsigned char* ws = F.ws; const bf16* H = (const bf16*)(ws + WS_H); const unsigned char* Y = ws + WS_Y;
    const int* tok_p = (const int*)(ws + WS_TOKR); const float* tok_g = (const float*)(ws + WS_TOKG); const float* fw = F.in[I_FNW];
    for (int t = gw; t < NT; t += NGW) {
        f32x4 v[8]; const v2u* hr = (const v2u*)(H + (size_t)t * DM) + lane;
#pragma unroll
        for (int j = 0; j < 8; ++j) { const v2u hx = hr[64 * j]; v[j] = (f32x4){bf_lo(hx.x), bf_hi(hx.x), bf_lo(hx.y), bf_hi(hx.y)}; }
#if DBG_PROBE
        { f32x4* orow_ = (f32x4*)(F.out + (size_t)t * DM) + lane;
#pragma unroll
          for (int j = 0; j < 8; ++j) { f32x4 q_;
#if DBG_PROBE_F32
              q_ = *((const f32x4*)((const float*)(ws + DBG_PROBE_OFF) + (size_t)t * DBG_PROBE_LD) + ((lane + 64 * j) % (DBG_PROBE_LD / 4)));
#else
              { const v2u r_ = *((const v2u*)((const bf16*)(ws + DBG_PROBE_OFF) + (size_t)t * DBG_PROBE_LD) + ((lane + 64 * j) % (DBG_PROBE_LD / 4))); q_[0] = bf_lo(r_.x); q_[1] = bf_hi(r_.x); q_[2] = bf_lo(r_.y); q_[3] = bf_hi(r_.y); }
#endif
              q_ = q_ * 64.f; q_[0] -= floorf(q_[0]); q_[1] -= floorf(q_[1]); q_[2] -= floorf(q_[2]); q_[3] -= floorf(q_[3]); orow_[64 * j] = q_; }
          continue; }
#endif
        if (!DBG_NO_MOE) {
#pragma unroll
            for (int k = 0; k < 4; ++k) { const int row = tok_p[t * 4 + k]; const float g = tok_g[t * 4 + k] * (1.f / Y8_SCALE); const unsigned* yr = (const unsigned*)(Y + (size_t)row * DM) + lane;
#pragma unroll
                for (int j = 0; j < 8; ++j) { const unsigned y = __builtin_nontemporal_load(yr + 64 * j);
                    const f32x2 lo = __builtin_amdgcn_cvt_pk_f32_fp8((int)y, false), hi = __builtin_amdgcn_cvt_pk_f32_fp8((int)y, true);
                    v[j][0] += g * lo[0]; v[j][1] += g * lo[1]; v[j][2] += g * hi[0]; v[j][3] += g * hi[1]; } }
        }
        float s = 0.f;
#pragma unroll
        for (int j = 0; j < 8; ++j) s += v[j][0] * v[j][0] + v[j][1] * v[j][1] + v[j][2] * v[j][2] + v[j][3] * v[j][3];
        const float rs = rsqrtf(wave_sum(s) * (1.f / DM) + RMS_EPS);
        f32x4* orow = (f32x4*)(F.out + (size_t)t * DM) + lane;
#pragma unroll
        for (int j = 0; j < 8; ++j) { const f32x4 g = *((const f32x4*)fw + lane + 64 * j); __builtin_nontemporal_store(v[j] * rs * g, orow + 64 * j); }
    }
}

struct Args { const float* in[26]; float* out; unsigned char* ws; int ph_lo, ph_hi; };
__global__ void __launch_bounds__(NWAVES * 64, 2) hymba_fwd(Args args) {
    extern __shared__ __attribute__((aligned(16))) unsigned char lds_raw[];
    Frame F;
    F.lds = (LAS unsigned char*)lds_raw;
    F.MISC = (volatile LAS unsigned*)(F.lds + MISC_OFF);
    F.tid = threadIdx.x; F.lane = F.tid & 63; F.wave = __builtin_amdgcn_readfirstlane(F.tid >> 6);
    F.G = gridDim.x; F.c = blockIdx.x;
    F.ws = args.ws; F.ctl = (gu32*)(args.ws + WS_CTL); F.out = args.out;
#pragma unroll
    for (int i = 0; i < 26; ++i) F.in[i] = args.in[i];
    for (int u = F.tid; u < (LDS_BYTES - MISC_OFF) / 4; u += NWAVES * 64) F.MISC[u] = 0u;
    __syncthreads();
    const int lo = args.ph_lo, hi = args.ph_hi;
    XcdBarrier bar; bar.bar = (unsigned*)(F.ctl + CW_BAR); bar.x = 0; bar.st = nullptr;
    if (hi - lo > 1) bar = xcd_barrier_post((unsigned*)(F.ctl + CW_BAR), F.MISC);
#ifdef ONLY_PHASE
#define IN(k) ((k) == ONLY_PHASE && lo <= (k) && (k) < hi)
#else
#define IN(k) (lo <= (k) && (k) < hi)
#endif
#define SEAM(k) do { if (IN(k) && IN((k) + 1)) xcd_barrier(bar); } while (0)
    unsigned char* ws = args.ws;
    const int G = F.G, c = F.c;

    if (IN(0)) { p0_prologue(F);
#if DBG_REP == 7
        xcd_barrier(bar); p0_prologue(F);
#endif
    }
    SEAM(0);
    if (IN(1)) {
        pg8::DenseOrder S; S.init(ws + WS_XN, DM, ws + WS_WIN, DM, NT, NIN_PAD, G, c);
        EpiInProj E{(bf16*)(ws + WS_PROJ), (bf16*)(ws + WS_KPE), (float*)(ws + WS_DT), (float*)(ws + WS_SSP), (const float*)(ws + WS_ROPE)};
        pg8::gemm_phase<false>(F.lds, pg8::Geo{DM, DM, DM}, S, E);
#if DBG_REP == 1
        xcd_barrier(bar); pg8::gemm_phase<false>(F.lds, pg8::Geo{DM, DM, DM}, S, E);
#endif
        {
          const int rem = ((NT / 256) * (NIN_PAD / 256)) % G, t0 = rem ? rem : 0;
          if (c >= t0) { const int st = (c - t0) * NWAVES + F.wave, sd = (G - t0) * NWAVES; dense_weights_tail(F, st, sd); moe_convert_range(F, 0, MOE_PRE1, st, sd); } }
#if DBG_REP == 22
        { xcd_barrier(bar); pg8::DenseOrder S2 = S; S2.tstepA = 0; S2.tstepB = 0; EpiNull E2{ws + WS_Y}; pg8::gemm_phase<false>(F.lds, pg8::Geo{DM, DM, DM}, S2, E2); }
#endif
#if DBG_REP == 21
        { xcd_barrier(bar); EpiNull E2{ws + WS_Y}; pg8::gemm_phase<false>(F.lds, pg8::Geo{DM, DM, DM}, S, E2); }
#endif
    }
    SEAM(1);
    if (IN(2)) {
#if DBG_REP == 2
        for (int u = c; u < BATCH * NCHUNK * NGRP * 2; u += G) ssd_local_unit(F, u);
        xcd_barrier(bar);
#endif
        for (int u = c; u < BATCH * NCHUNK * NGRP * 2; u += G) ssd_local_unit(F, u);
        __syncthreads();
        { pg8::DenseOrder S; S.init(ws + WS_PROJ + (size_t)PC_QA * 2, NPROJ, ws + WS_WQB, Q_LORA, NT, MLA_H * QKD, G, c);
          EpiQB E{(bf16*)(ws + WS_Q), (const float*)(ws + WS_SSP), (const float*)(ws + WS_ROPE)};
          pg8::gemm_phase<false>(F.lds, pg8::Geo{NPROJ, Q_LORA, Q_LORA}, S, E); }
        { pg8::DenseOrder S; S.init(ws + WS_PROJ + (size_t)PC_KVA * 2, NPROJ, ws + WS_WKVB, KV_LORA, NT, MLA_H * 256, G, c); S.skew = 0;
          EpiKVB E{(bf16*)(ws + WS_KN), (bf16*)(ws + WS_V), (const float*)(ws + WS_SSP)};
          pg8::gemm_phase<false>(F.lds, pg8::Geo{NPROJ, KV_LORA, KV_LORA}, S, E); }
        {
          const int rem = ((NT / 256) * (MLA_H * QKD / 256)) % G, t0 = rem ? rem : 0;
          if (c >= t0) moe_convert_range(F, MOE_PRE1, MOE_PRE1 + MOE_PRE2, (c - t0) * NWAVES + F.wave, (G - t0) * NWAVES); }
    }
    SEAM(2);
    if (IN(3)) {
        const int x = c & 7, q = c >> 3, G8 = G >> 3;
        const int team = x * 2 + ((q >> 4) & 1), grp = team % 3;
        const int nteam = 2 * 8, gteams = (nteam - grp + 2) / 3, grank = (team / 3) * 16 + (q & 15), gsize = gteams * 16;
        constexpr int NREM = MOE_NIT - MOE_PRE1 - MOE_PRE2;
        const int tb0 = (grp == 0) ? 0 : (grp == 1) ? (nteam + 2) / 3 : (nteam + 2) / 3 + (nteam + 1) / 3, tb1 = tb0 + gteams;
        const int cv_lo = MOE_PRE1 + MOE_PRE2 + (int)((long)tb0 * NREM / nteam), cv_hi = MOE_PRE1 + MOE_PRE2 + (int)((long)tb1 * NREM / nteam);
#if DBG_REP == 3
#pragma unroll 1
        for (int rep_ = 0; rep_ < 2; ++rep_) { if (rep_) xcd_barrier(bar);
#else
        { constexpr int rep_ = 0;
#endif
#pragma unroll 1
        for (int s = 0; ; ++s) {
            if (s == grp && rep_ == 0) { for (int it = c; it < BATCH * SSM_HEADS * 2 * 2; it += G) ssd_scan_item(F, it); moe_convert_range(F, cv_lo, cv_hi, grank * NWAVES + F.wave, gsize * NWAVES); }
            const int v = s * G8 + q; const int pr = v >> 4, qb = v & 15;
            if (pr >= 4) { if (s >= grp) break; else continue; }
            const int pair = pr * 8 + x, b = pair >> 3, h = pair & 7;
            const size_t bh = (size_t)(b * MLA_H + h);
            att::attn_unit((const bf16*)(ws + WS_Q) + (bh * SEQ + qb * 256) * QKD, (const bf16*)(ws + WS_KN) + bh * SEQ * 128, (const bf16*)(ws + WS_KPE) + (size_t)b * SEQ * 64,
                           (const bf16*)(ws + WS_V) + bh * SEQ * 128, (bf16*)(ws + WS_O) + ((size_t)(b * SEQ + qb * 256)) * 1024 + h * 128, F.lds);
        }
        }
    }
    SEAM(3);
    if (IN(4)) {
#if DBG_REP == 4
        for (int u = c; u < BATCH * NCHUNK * NGRP; u += G) ssd_out_unit(F, u);
        xcd_barrier(bar);
#endif
        for (int u = c; u < BATCH * NCHUNK * NGRP; u += G) ssd_out_unit(F, u);
        att_norm_rows(F);
    }
    SEAM(4);
    if (IN(5)) {
        pg8::DenseOrder S; S.init(ws + WS_YCAT, DM, ws + WS_WOUT, DM, NT, DM, G, c);
        EpiOut E{F.in[I_X], (bf16*)(ws + WS_H), (float*)(ws + WS_SS2P)};
        pg8::gemm_phase<false>(F.lds, pg8::Geo{DM, DM, DM}, S, E);
#if DBG_REP == 9 + 1
        xcd_barrier(bar); pg8::gemm_phase<false>(F.lds, pg8::Geo{DM, DM, DM}, S, E);
#endif
    }
    SEAM(5);
    if (IN(6)) { router_phase(F);
#if DBG_REP == 6
        xcd_barrier(bar); router_phase(F);
#endif
#if DBG_REP == 16
        xcd_barrier(bar); router_phase<1>(F);
#endif
#if DBG_REP == 17
        xcd_barrier(bar); router_phase<2>(F);
#endif
    }
    SEAM(6);
    if (IN(7)) { moe_tables(F, true); gather_phase(F);
#if DBG_REP == 11
        xcd_barrier(bar); moe_tables(F, true); gather_phase(F);
#endif
    }
    SEAM(7);
    if (IN(8)) {
        if (!IN(7)) moe_tables(F, false);
        MoeOrder<2> S; S.init(ws + WS_XN, DM / 2, ws + WS_WGU, DM / 2, (size_t)4096 * DM, (const LAS int*)(F.lds + MISC_OFF) + 128, (int)F.MISC[48], G, c);
        S.rtok = (const int*)(ws + WS_XG);
        EpiGU E{ws + WS_ACT, F.in[I_BGU]};
        pg8::gemm_phase<true, EpiGU, MoeOrder<2>, false, true>(F.lds, pg8::Geo{DM / 2, DM / 2, DM / 2}, S, E);
#if DBG_REP == 8
        { xcd_barrier(bar); EpiGU E2{ws + WS_Y, F.in[I_BGU]}; pg8::gemm_phase<true, EpiGU, MoeOrder<2>, false, true>(F.lds, pg8::Geo{DM / 2, DM / 2, DM / 2}, S, E2); }
#endif
#if DBG_REP == 15
        { xcd_barrier(bar); EpiNull E2{ws + WS_Y}; pg8::gemm_phase<true, EpiNull, MoeOrder<2>, false, true>(F.lds, pg8::Geo{DM / 2, DM / 2, DM / 2}, S, E2); }
#endif
    }
    SEAM(8);
    if (IN(9)) {
        if (!IN(7)) moe_tables(F, false);
        MoeOrder<1> S; S.init(ws + WS_ACT, DEXP / 2, ws + WS_WDN, DEXP / 2, (size_t)DM * DEXP, (const LAS int*)(F.lds + MISC_OFF) + 128, (int)F.MISC[48], G, c);
        EpiDN E{ws + WS_Y, F.in[I_BDN]};
        pg8::gemm_phase<true>(F.lds, pg8::Geo{DEXP / 2, DEXP / 2, DEXP / 2}, S, E);
#if DBG_REP == 9
        xcd_barrier(bar); pg8::gemm_phase<true>(F.lds, pg8::Geo{DEXP / 2, DEXP / 2, DEXP / 2}, S, E);
#endif
    }
    SEAM(9);
#if DBG_REP == 12
    for (int rb_ = 0; rb_ < 10; ++rb_) xcd_barrier(bar);
#endif
#if DBG_REP == 13
    if (IN(2)) { pg8::DenseOrder S; S.init(ws + WS_PROJ + (size_t)PC_QA * 2, NPROJ, ws + WS_WQB, Q_LORA, NT, MLA_H * QKD, G, c);
          EpiQB E{(bf16*)(ws + WS_Q), (const float*)(ws + WS_SSP), (const float*)(ws + WS_ROPE)};
          pg8::gemm_phase<false>(F.lds, pg8::Geo{NPROJ, Q_LORA, Q_LORA}, S, E);
          pg8::DenseOrder S2; S2.init(ws + WS_PROJ + (size_t)PC_KVA * 2, NPROJ, ws + WS_WKVB, KV_LORA, NT, MLA_H * 256, G, c);
          EpiKVB E2{(bf16*)(ws + WS_KN), (bf16*)(ws + WS_V), (const float*)(ws + WS_SSP)};
          pg8::gemm_phase<false>(F.lds, pg8::Geo{NPROJ, KV_LORA, KV_LORA}, S2, E2); xcd_barrier(bar); }
#endif
    if (IN(10)) { final_phase(F);
#if DBG_REP == 5
        xcd_barrier(bar); final_phase(F);
#endif
    }
#undef IN
#undef SEAM
}

extern "C" void kernel_launch(void* const* d_in, const int* in_sizes, int n_in, void* d_out, int out_size, void* d_ws, size_t ws_size, hipStream_t stream) {
    static int grid = 0;
    if (grid == 0) {
        if (n_in != 26 || in_sizes[0] != NT * DM || out_size != NT * DM || ws_size < WS_END) { fprintf(stderr, "kernel_launch: unexpected shapes (n_in %d, in0 %d, out %d, ws %zu < %zu)\n", n_in, n_in > 0 ? in_sizes[0] : -1, out_size, ws_size, (size_t)WS_END); grid = -1; return; }
        int dev = 0, cus = 0, per_cu = 0;
        if (hipGetDevice(&dev) != hipSuccess || hipDeviceGetAttribute(&cus, hipDeviceAttributeMultiprocessorCount, dev) != hipSuccess) { grid = -1; return; }
        if (hipFuncSetAttribute((const void*)hymba_fwd, hipFuncAttributeMaxDynamicSharedMemorySize, LDS_BYTES) != hipSuccess) { fprintf(stderr, "kernel_launch: hipFuncSetAttribute failed\n"); grid = -1; return; }
        if (hipOccupancyMaxActiveBlocksPerMultiprocessor(&per_cu, (const void*)hymba_fwd, NWAVES * 64, LDS_BYTES) != hipSuccess || per_cu < 1) { fprintf(stderr, "kernel_launch: occupancy query says %d blocks per CU\n", per_cu); }
        (void)hipGetLastError();
        grid = cus;
        if (grid % 8 != 0) { fprintf(stderr, "kernel_launch: grid %d is not a multiple of 8\n", grid); grid = -1; return; }
    }
    if (grid < 0) return;
    if (hipMemsetAsync((char*)d_ws + WS_CTL, 0, CTL_ZERO_BYTES, stream) != hipSuccess) return;
    Args a{};
    for (int i = 0; i < 26; ++i) a.in[i] = (const float*)d_in[i];
    a.out = (float*)d_out; a.ws = (unsigned char*)d_ws;
#if MK_N_LAUNCHES == 1
    a.ph_lo = 0; a.ph_hi = NPHASE;
    hipLaunchKernelGGL(hymba_fwd, dim3(grid), dim3(NWAVES * 64), LDS_BYTES, stream, a);
#else
    for (int p = 0; p < NPHASE; ++p) { a.ph_lo = p; a.ph_hi = p + 1; hipLaunchKernelGGL(hymba_fwd, dim3(grid), dim3(NWAVES * 64), LDS_BYTES, stream, a); }
#endif
    const hipError_t le = hipPeekAtLastError();
    if (le != hipSuccess) fprintf(stderr, "kernel_launch: launch failed: %s\n", hipGetErrorName(le));
}
```
